# Optimizing an MI355X kernel written in HIP

```python
import jax, jax.numpy as jnp
from jax import lax
import numpy as np

D_MODEL = 1024
BATCH = 16
SEQ = 256
DEPTH = 2
DEC_BATCH = 8
DEC_SEQ = 4096
PAST_LEN = 256

F32 = jnp.float32
GRID_W = 64
N_BRANCH = 4
BRANCH_W = D_MODEL // 2
HG_DK = 128
HG_DV = 128
HG_HEADS = BRANCH_W // HG_DK
HG_CHUNK = 64
NA_DH = 64
NA_HEADS = BRANCH_W // NA_DH
WIN_R = 8
WIN_C = 16
NOPE_DIM = 128
ROPE_DIM = 64
V_DIM = 128
MLA_HEADS = BRANCH_W // V_DIM
Q_RANK = 256
KV_RANK = 128
ROPE_THETA = 10000.0
CONV_W = 3
Q_BLOCK = 128
EPS = 1e-6
DEEPNORM_ALPHA = (2 * DEPTH) ** 0.25
DEEPNORM_BETA = (8 * DEPTH) ** -0.25

SPLIT_SIZES = (
    BRANCH_W, BRANCH_W, BRANCH_W, BRANCH_W, BRANCH_W,
    BRANCH_W, BRANCH_W, BRANCH_W, BRANCH_W,
    Q_RANK, KV_RANK, ROPE_DIM, BRANCH_W,
    BRANCH_W, BRANCH_W, BRANCH_W, BRANCH_W,
    N_BRANCH * D_MODEL,
)
IN_W = sum(SPLIT_SIZES)

kernel_name = 'hybrid_diffusion_parallel_branch_step'


def split_columns(z):
    points = np.cumsum(np.array(SPLIT_SIZES))[:-1].tolist()
    return jnp.split(z, points, axis=-1)


def layer_norm(x, g, b):
    xf = x.astype(F32)
    mu = jnp.mean(xf, axis=-1, keepdims=True)
    var = jnp.mean(jnp.square(xf - mu), axis=-1, keepdims=True)
    return ((xf - mu) * lax.rsqrt(var + EPS)).astype(x.dtype) * g + b


def rms_norm(x, g):
    xf = x.astype(F32)
    y = xf * lax.rsqrt(jnp.mean(jnp.square(xf), axis=-1, keepdims=True) + EPS)
    return y.astype(x.dtype) * g


def axial_rope(x):
    T = x.shape[1]
    t = jnp.arange(T)
    row = (t // GRID_W).astype(F32)
    col = (t % GRID_W).astype(F32)
    n_pair_axis = ROPE_DIM // 4
    inv = 1.0 / (ROPE_THETA ** (jnp.arange(n_pair_axis, dtype=F32) / n_pair_axis))
    ang = jnp.concatenate([row[:, None] * inv, col[:, None] * inv], axis=-1)
    cos = jnp.cos(ang)[None, :, None, :].astype(x.dtype)
    sin = jnp.sin(ang)[None, :, None, :].astype(x.dtype)
    x1, x2 = x[..., :ROPE_DIM // 2], x[..., ROPE_DIM // 2:]
    return jnp.concatenate([x1 * cos - x2 * sin, x1 * sin + x2 * cos], axis=-1)


def blocked_attention(q, k, v, scale):
    B, Tq, H, dq = q.shape
    qb = jnp.moveaxis(q.reshape(B, Tq // Q_BLOCK, Q_BLOCK, H, dq), 1, 0)

    def attend(q_blk):
        s = jnp.einsum('bqhd,bkhd->bhqk', q_blk, k).astype(F32) * scale
        p = jax.nn.softmax(s, axis=-1).astype(v.dtype)
        return jnp.einsum('bhqk,bkhe->bqhe', p, v)

    o = lax.map(attend, qb)
    return jnp.moveaxis(o, 0, 1).reshape(B, Tq, H, v.shape[-1])


def neighbourhood_attention(q, k, v, ck, cv, rpb):
    B, T, H, d = q.shape
    rows = T // GRID_W
    wr = min(WIN_R, rows)
    scale = d ** -0.5
    q5 = q.reshape(B, rows, GRID_W, H, d)
    k5 = k.reshape(B, rows, GRID_W, H, d)
    v5 = v.reshape(B, rows, GRID_W, H, d)
    cols = jnp.arange(GRID_W)
    col_start = jnp.clip(cols - WIN_C // 2, 0, GRID_W - WIN_C)
    col_idx = col_start[:, None] + jnp.arange(WIN_C)[None, :]
    col_off = col_idx - cols[:, None] + (WIN_C - 1)

    def row_block(r):
        rs = jnp.clip(r - wr // 2, 0, rows - wr)
        qr = lax.dynamic_index_in_dim(q5, r, axis=1, keepdims=False)
        kg = lax.dynamic_slice_in_dim(k5, rs, wr, axis=1)[:, :, col_idx]
        vg = lax.dynamic_slice_in_dim(v5, rs, wr, axis=1)[:, :, col_idx]
        row_off = rs + jnp.arange(wr) - r + (WIN_R - 1)
        bias = jnp.transpose(rpb[:, row_off][:, :, col_off], (0, 2, 1, 3))
        s_loc = jnp.einsum('bqhd,brqchd->bhqrc', qr, kg).astype(F32) * scale + bias[None].astype(F32)
        s_ctx = jnp.einsum('bqhd,bkhd->bhqk', qr, ck).astype(F32) * scale
        n_loc = wr * WIN_C
        s = jnp.concatenate([s_loc.reshape(B, H, GRID_W, n_loc), s_ctx], axis=-1)
        p = jax.nn.softmax(s, axis=-1).astype(v.dtype)
        p_loc = p[..., :n_loc].reshape(B, H, GRID_W, wr, WIN_C)
        return (jnp.einsum('bhqrc,brqchd->bqhd', p_loc, vg)
                + jnp.einsum('bhqk,bkhd->bqhd', p[..., n_loc:], cv))

    out = lax.map(row_block, jnp.arange(rows))
    return jnp.moveaxis(out, 0, 1).reshape(B, T, H, d)


def hgrn_gates(f_raw, lb):
    log_g = jnp.logaddexp(jnp.log(lb), jnp.log1p(-lb) + jax.nn.log_sigmoid(f_raw.astype(F32)))
    return log_g, -jnp.expm1(log_g)


def chunk_gla(q, k, v, log_g, s0):
    B, T, H, dk = q.shape
    dv = v.shape[-1]
    L = HG_CHUNK
    n = T // L

    def to_chunks(a):
        return jnp.transpose(a.astype(F32).reshape(B, n, L, H, a.shape[-1]), (1, 0, 3, 2, 4))

    causal = jnp.tril(jnp.ones((L, L), dtype=bool))

    def step(S, inp):
        qc, kc, vc, gc = inp
        b = jnp.cumsum(gc, axis=2)
        diff = b[:, :, :, None, :] - b[:, :, None, :, :]
        decay = jnp.exp(jnp.where(causal[:, :, None], diff, -jnp.inf))
        attn = jnp.einsum('bhtd,bhsd,bhtsd->bhts', qc, kc, decay)
        o = (jnp.einsum('bhts,bhse->bhte', attn, vc)
             + jnp.einsum('bhtd,bhde->bhte', qc * jnp.exp(b), S))
        b_last = b[:, :, -1:, :]
        S = (jnp.exp(b_last[:, :, 0, :, None]) * S
             + jnp.einsum('bhsd,bhse->bhde', kc * jnp.exp(b_last - b), vc))
        return S, o

    s_fin, o = lax.scan(step, s0.astype(F32),
                        (to_chunks(q), to_chunks(k), to_chunks(v), to_chunks(log_g)))
    return jnp.transpose(o, (1, 0, 3, 2, 4)).reshape(B, T, H, dv), s_fin


def hgrn2_branch(q_raw, ff_raw, fb_raw, i_raw, g_raw, lb_f, lb_b, norm_g, s0_f, s0_b):
    B, T, _ = q_raw.shape

    def heads(a, d):
        return a.reshape(B, T, HG_HEADS, d)

    def rev(a):
        return jnp.flip(a, axis=1)

    q = heads(jax.nn.silu(q_raw.astype(F32)), HG_DK)
    v = heads(i_raw.astype(F32), HG_DV)
    lg_f, k_f = hgrn_gates(ff_raw, lb_f)
    lg_b, k_b = hgrn_gates(fb_raw, lb_b)
    o_f, s_f = chunk_gla(q, heads(k_f, HG_DK), v, heads(lg_f, HG_DK), s0_f)
    o_b, s_b = chunk_gla(rev(q), rev(heads(k_b, HG_DK)), rev(v), rev(heads(lg_b, HG_DK)), s0_b)
    o = rms_norm(o_f + rev(o_b), norm_g).reshape(B, T, BRANCH_W).astype(g_raw.dtype)
    return o * jax.nn.silu(g_raw), s_f, s_b


def mla_expand_kv(ckv, w_kvb):
    B, T, _ = ckv.shape
    kv = (ckv @ w_kvb).reshape(B, T, MLA_HEADS, NOPE_DIM + V_DIM)
    return kv[..., :NOPE_DIM], kv[..., NOPE_DIM:]


def mla_keys(k_nope, kpe):
    kpe_h = jnp.broadcast_to(kpe[:, :, None, :], k_nope.shape[:3] + (ROPE_DIM,))
    return jnp.concatenate([k_nope, kpe_h], axis=-1)


def short_conv(u, w):
    return lax.conv_general_dilated(u, w[:, None, :], window_strides=(1,),
                                    padding=((CONV_W // 2, CONV_W // 2),),
                                    dimension_numbers=('NWC', 'WIO', 'NWC'),
                                    feature_group_count=u.shape[-1])


def trunk_layer(x, cvec, ctx_cache, w_ada, b_ada, w_in, b_in, lb_f, lb_b, hg_norm_g, na_rpb,
                mla_qnorm_g, mla_w_qb, mla_kvnorm_g, mla_w_kvb, conv_w, w_branch, w_out, ln_g, ln_b):
    B, T, _ = x.shape
    is_ctx = ctx_cache is None
    mod = (jax.nn.silu(cvec) @ w_ada + b_ada).reshape(-1, 1, 3 * D_MODEL)
    shift, scale, gate = jnp.split(mod, 3, axis=-1)
    h = x * (1 + scale) + shift
    (a_q, a_ff, a_fb, a_i, a_g, b_q, b_k, b_v, b_g, c_qd, c_kvd, c_kpe, c_g,
     d_b, d_c, d_x, d_g, merge) = split_columns(h @ w_in + b_in)

    if is_ctx:
        s0 = jnp.zeros((B, 2, HG_HEADS, HG_DK, HG_DV), F32)
    else:
        s0 = ctx_cache[0].astype(F32)
    out_a, s_f, s_b = hgrn2_branch(a_q, a_ff, a_fb, a_i, a_g, lb_f, lb_b, hg_norm_g,
                                   s0[:, 0], s0[:, 1])

    q_na = b_q.reshape(B, T, NA_HEADS, NA_DH)
    k_na = b_k.reshape(B, T, NA_HEADS, NA_DH)
    v_na = b_v.reshape(B, T, NA_HEADS, NA_DH)
    if is_ctx:
        o_na = blocked_attention(q_na, k_na, v_na, NA_DH ** -0.5)
    else:
        o_na = neighbourhood_attention(q_na, k_na, v_na, ctx_cache[1], ctx_cache[2], na_rpb)
    out_b = o_na.reshape(B, T, BRANCH_W) * jax.nn.silu(b_g)

    q_mla = (rms_norm(c_qd, mla_qnorm_g) @ mla_w_qb).reshape(B, T, MLA_HEADS, NOPE_DIM + ROPE_DIM)
    ckv = rms_norm(c_kvd, mla_kvnorm_g)
    k_nope, v_mla = mla_expand_kv(ckv, mla_w_kvb)
    if is_ctx:
        keys = mla_keys(k_nope, c_kpe)
        vals = v_mla
    else:
        q_mla = jnp.concatenate([q_mla[..., :NOPE_DIM], axial_rope(q_mla[..., NOPE_DIM:])], axis=-1)
        kpe_lat = axial_rope(c_kpe[:, :, None, :])[:, :, 0]
        kn_ctx, v_ctx = mla_expand_kv(ctx_cache[3], mla_w_kvb)
        keys = jnp.concatenate([mla_keys(k_nope, kpe_lat), mla_keys(kn_ctx, ctx_cache[4])], axis=1)
        vals = jnp.concatenate([v_mla, v_ctx], axis=1)
    o_mla = blocked_attention(q_mla, keys, vals, (NOPE_DIM + ROPE_DIM) ** -0.5)
    out_c = o_mla.reshape(B, T, BRANCH_W) * jax.nn.silu(c_g)

    out_d = d_b * short_conv(d_c * d_x, conv_w) * jax.nn.silu(d_g)

    branches = jnp.stack([out_a, out_b, out_c, out_d], axis=2)
    proj = jnp.einsum('btnw,nwd->btnd', branches, w_branch)
    gates = jax.nn.sigmoid(merge).reshape(B, T, N_BRANCH, D_MODEL)
    mixed = jnp.einsum('btnd,btnd->btd', gates, proj) @ w_out
    y = layer_norm(DEEPNORM_ALPHA * x + gate * mixed, ln_g, ln_b)
    if is_ctx:
        states = jnp.stack([s_f, s_b], axis=1).astype(x.dtype)
        return y, (states, k_na, v_na, ckv, c_kpe)
    return y, None


def setup_inputs(seed: int = 0) -> dict:
    key = jax.random.key(seed)
    ks = jax.random.split(key, 26)

    def nrm(i, shape, s):
        return jax.random.normal(ks[i], shape, F32) * s

    return {
        'x_prompt': nrm(0, (BATCH, SEQ, D_MODEL), 1.0),
        'x_sample': nrm(1, (DEC_BATCH, DEC_SEQ, D_MODEL), 1.0),
        'state_hgrn': nrm(2, (DEC_BATCH, DEPTH, 2, HG_HEADS, HG_DK, HG_DV), 0.5),
        'cache_na_k': nrm(3, (DEC_BATCH, DEPTH, PAST_LEN, NA_HEADS, NA_DH), 1.0),
        'cache_na_v': nrm(4, (DEC_BATCH, DEPTH, PAST_LEN, NA_HEADS, NA_DH), 1.0),
        'cache_mla_ckv': nrm(5, (DEC_BATCH, DEPTH, PAST_LEN, KV_RANK), 1.0),
        'cache_mla_kpe': nrm(6, (DEC_BATCH, DEPTH, PAST_LEN, ROPE_DIM), 1.0),
        'c': nrm(7, (DEC_BATCH, D_MODEL), 1.0),
        'c_ctx': nrm(8, (D_MODEL,), 1.0),
        'w_ada': nrm(9, (DEPTH, D_MODEL, 3 * D_MODEL), 0.5 * D_MODEL ** -0.5),
        'b_ada': nrm(10, (DEPTH, 3 * D_MODEL), 0.01),
        'w_in': nrm(11, (DEPTH, D_MODEL, IN_W), D_MODEL ** -0.5),
        'b_in': nrm(12, (DEPTH, IN_W), 0.01),
        'hg_lb_logits': nrm(13, (2, DEPTH, BRANCH_W), 0.5),
        'hg_norm_g': 1.0 + nrm(14, (DEPTH, HG_DV), 0.02),
        'na_rpb': nrm(15, (DEPTH, NA_HEADS, 2 * WIN_R - 1, 2 * WIN_C - 1), 0.02),
        'mla_qnorm_g': 1.0 + nrm(16, (DEPTH, Q_RANK), 0.02),
        'mla_w_qb': nrm(17, (DEPTH, Q_RANK, MLA_HEADS * (NOPE_DIM + ROPE_DIM)), Q_RANK ** -0.5),
        'mla_kvnorm_g': 1.0 + nrm(18, (DEPTH, KV_RANK), 0.02),
        'mla_w_kvb': nrm(19, (DEPTH, KV_RANK, MLA_HEADS * (NOPE_DIM + V_DIM)), KV_RANK ** -0.5),
        'conv_w': nrm(20, (DEPTH, CONV_W, BRANCH_W), CONV_W ** -0.5),
        'w_branch': nrm(21, (DEPTH, N_BRANCH, BRANCH_W, D_MODEL), DEEPNORM_BETA * BRANCH_W ** -0.5),
        'w_out': nrm(22, (DEPTH, D_MODEL, D_MODEL), DEEPNORM_BETA * D_MODEL ** -0.5),
        'ln_g': 1.0 + nrm(23, (DEPTH, D_MODEL), 0.02),
        'ln_b': nrm(24, (DEPTH, D_MODEL), 0.01),
    }


def reference(x_prompt, x_sample, state_hgrn, cache_na_k, cache_na_v, cache_mla_ckv, cache_mla_kpe,
              c, c_ctx, w_ada, b_ada, w_in, b_in, hg_lb_logits, hg_norm_g, na_rpb, mla_qnorm_g,
              mla_w_qb, mla_kvnorm_g, mla_w_kvb, conv_w, w_branch, w_out, ln_g, ln_b):
    lb = jnp.cumsum(jax.nn.softmax(hg_lb_logits.astype(F32), axis=1), axis=1)
    lb = lb - lb[:, :1]
    y_p = x_prompt
    y_s = x_sample
    hg_s, na_k, na_v, mla_ckv, mla_kpe = [], [], [], [], []
    for l in range(DEPTH):
        weights = (w_ada[l], b_ada[l], w_in[l], b_in[l], lb[0, l], lb[1, l], hg_norm_g[l], na_rpb[l],
                   mla_qnorm_g[l], mla_w_qb[l], mla_kvnorm_g[l], mla_w_kvb[l], conv_w[l],
                   w_branch[l], w_out[l], ln_g[l], ln_b[l])
        y_p, ctx_l = trunk_layer(y_p, c_ctx, None, *weights)
        hg_s.append(ctx_l[0])
        na_k.append(ctx_l[1])
        na_v.append(ctx_l[2])
        mla_ckv.append(ctx_l[3])
        mla_kpe.append(ctx_l[4])
        cache_l = (state_hgrn[:, l], cache_na_k[:, l], cache_na_v[:, l],
                   cache_mla_ckv[:, l], cache_mla_kpe[:, l])
        y_s, _ = trunk_layer(y_s, c, cache_l, *weights)
    new_state_hgrn = jnp.stack(hg_s, axis=1)
    new_na_k = jnp.stack(na_k, axis=1)
    new_na_v = jnp.stack(na_v, axis=1)
    new_mla_ckv = jnp.stack(mla_ckv, axis=1)
    new_mla_kpe = jnp.stack(mla_kpe, axis=1)
    return (y_p, y_s, new_state_hgrn, new_na_k, new_na_v, new_mla_ckv, new_mla_kpe)
```

```cpp
#include <hip/hip_runtime.h>
#include <hip/hip_cooperative_groups.h>
#include <cstdio>
namespace cg = cooperative_groups;

typedef unsigned short bf16;
typedef __attribute__((ext_vector_type(8))) short bf16x8;
typedef __attribute__((ext_vector_type(16))) float f32x16;
#define DEV __device__ __forceinline__
#define MFMA(a, b, c) __builtin_amdgcn_mfma_f32_32x32x16_bf16((a), (b), (c), 0, 0, 0)

constexpr int ZW = 11712, ZS = 7616, GU = 3, GT = GU * 4096, UT = 4096, KVR = 4352;
constexpr float LOG2E = 1.4426950408889634f;
constexpr float QS_NA = 0.125f * LOG2E;
constexpr float QS_MLA = 0.07216878364870322f * LOG2E;
constexpr float EPS = 1e-6f;
constexpr float ALPHA = 1.4142135623730951f;
constexpr int C_AQ = 0, C_AFF = 512, C_AFB = 1024, C_AI = 1536, C_AG = 2048, C_BQ = 2560, C_BK = 3072,
              C_BV = 3584, C_BG = 4096, C_QD = 4608, C_KVD = 4864, C_KPE = 4992, C_CG = 5056, C_DB = 5568,
              C_DC = 6080, C_DX = 6592, C_DG = 7104, C_MG = 7616;
constexpr size_t O_ST = 37748736, O_NK = 41943040, O_NV = 46137344, O_CKV = 50331648, O_KPE = 51380224;

constexpr size_t al(size_t x) { return (x + 255) & ~(size_t)255; }
constexpr size_t W_CTR = 0;
constexpr size_t W_WIN = 16384;
constexpr size_t W_WBR = W_WIN + al((size_t)2 * ZW * 1024 * 2);
constexpr size_t W_WOUT = W_WBR + al((size_t)2 * 4 * 1024 * 512 * 2);
constexpr size_t W_WQB = W_WOUT + al((size_t)2 * 1024 * 1024 * 2);
constexpr size_t W_WKVB = W_WQB + al((size_t)2 * 768 * 256 * 2);
constexpr size_t W_MOD = W_WKVB + al((size_t)2 * 1024 * 128 * 2);
constexpr size_t W_CK = W_MOD + al((size_t)2 * 9 * 3072 * 4);
constexpr size_t W_CVT = W_CK + al((size_t)8 * 2 * 8 * 256 * 64 * 2);
constexpr size_t W_H = W_CVT + al((size_t)8 * 2 * 8 * 256 * 64 * 2);
constexpr size_t W_Z = W_H + al((size_t)GT * 1024 * 2);
constexpr size_t W_LGF = W_Z + al((size_t)GT * ZS * 2);
constexpr size_t W_LGB = W_LGF + (size_t)GT * 512 * 4;
constexpr size_t W_SU = W_LGB + (size_t)GT * 512 * 4;
constexpr size_t W_G = W_LGF;
constexpr size_t W_KVPE = W_SU + al((size_t)(GT / 64) * 8 * 16384 * 2);
constexpr size_t W_NVT = W_KVPE + al((size_t)GT * 192 * 4);
constexpr size_t W_QN = W_NVT + al((size_t)512 * GT * 2);
constexpr size_t W_QM = W_QN + (size_t)GT * 256 * 2;
constexpr size_t W_MB = W_QN;
constexpr size_t W_CKVB = W_QM + al((size_t)GT * 768 * 2);
constexpr size_t W_KPER = W_CKVB + al((size_t)GU * KVR * 128 * 2);
constexpr size_t W_KN = W_KPER + al((size_t)GU * KVR * 64 * 2);
constexpr size_t W_VT = W_KN + al((size_t)GU * KVR * 512 * 2);
constexpr size_t W_BL = W_VT + al((size_t)GU * 512 * KVR * 2);
constexpr size_t W_CM = W_BL + al((size_t)(GT / 64) * 8 * 128 * 4);
constexpr size_t W_BR = W_CM + al((size_t)(GT / 64) * 8 * 128 * 4);
constexpr size_t W_END = W_BR + al((size_t)GT * 2048 * 2);
static_assert(W_END <= (size_t)512 * 1024 * 1024, "workspace layout exceeds 512 MiB");

constexpr int LDS_BYTES = 73728;
#ifndef DUP
#define DUP 0
#endif

struct P {
  const float *x_prompt, *x_sample, *state_hgrn, *cache_na_k, *cache_na_v, *cache_ckv, *cache_kpe, *c, *c_ctx,
      *w_ada, *b_ada, *w_in, *b_in, *lb_logits, *hg_norm_g, *na_rpb, *qnorm_g, *w_qb, *kvnorm_g, *w_kvb,
      *conv_w, *w_branch, *w_out, *ln_g, *ln_b;
  float* out;
  char* ws;
};

DEV bf16 f2bf(float f) { unsigned u = __float_as_uint(f); u += 0x7fffu + ((u >> 16) & 1u); return (bf16)(u >> 16); }
DEV float bf2f(bf16 b) { return __uint_as_float(((unsigned)b) << 16); }
DEV unsigned pack2(float a, float b) { unsigned r; asm("v_cvt_pk_bf16_f32 %0, %1, %2" : "=v"(r) : "v"(a), "v"(b)); return r; }
DEV float silu(float x) { return x * __builtin_amdgcn_rcpf(1.f + __expf(-x)); }
DEV float sigm(float x) { return __builtin_amdgcn_rcpf(1.f + __expf(-x)); }
DEV float ex2(float x) { return __builtin_amdgcn_exp2f(x); }
DEV int ltid() { int t = threadIdx.x; asm volatile("" : "+v"(t)); return t; }
typedef unsigned u32x2 __attribute__((ext_vector_type(2)));
DEV u32x2 lds_rd64(unsigned addr) { u32x2 v; asm volatile("ds_read_b64 %0, %1" : "=v"(v) : "v"(addr)); return v; }
DEV unsigned lds_addr(const void* p) { return (unsigned)(size_t)(__attribute__((address_space(3))) const char*)p; }
DEV bf16x8 comb2(u32x2 a, u32x2 b) { uint4 u = make_uint4(a.x, a.y, b.x, b.y); return *(bf16x8*)&u; }
DEV float xhalf_max(float x) {
  auto r = __builtin_amdgcn_permlane32_swap(__float_as_uint(x), __float_as_uint(x), false, false);
  return fmaxf(__uint_as_float(r[0]), __uint_as_float(r[1]));
}
DEV int rowoff(int reg, int hh) { return (reg & 3) + 8 * (reg >> 2) + 4 * hh; }
DEV bf16x8 packf8(const f32x16& x, int s) {
  uint4 u;
  u.x = pack2(x[8 * s + 0], x[8 * s + 1]); u.y = pack2(x[8 * s + 2], x[8 * s + 3]);
  u.z = pack2(x[8 * s + 4], x[8 * s + 5]); u.w = pack2(x[8 * s + 6], x[8 * s + 7]);
  return *(bf16x8*)&u;
}
typedef __bf16 nbf16x2 __attribute__((ext_vector_type(2)));
typedef float nf32x2 __attribute__((ext_vector_type(2)));
DEV unsigned pack2n(float a, float b) { nf32x2 v = {a, b}; nbf16x2 h = __builtin_convertvector(v, nbf16x2); return *(unsigned*)&h; }
DEV bf16x8 packf8n(const f32x16& x, int s) {
  uint4 u;
  u.x = pack2n(x[8 * s + 0], x[8 * s + 1]); u.y = pack2n(x[8 * s + 2], x[8 * s + 3]);
  u.z = pack2n(x[8 * s + 4], x[8 * s + 5]); u.w = pack2n(x[8 * s + 6], x[8 * s + 7]);
  return *(bf16x8*)&u;
}
DEV bf16x8 comb(uint2 a, uint2 b) { uint4 u = make_uint4(a.x, a.y, b.x, b.y); return *(bf16x8*)&u; }
DEV const float* xin_row(const P& p, int g) {
  return g < UT ? p.x_prompt + (size_t)g * 1024 : p.x_sample + (size_t)(g - UT) * 1024;
}
DEV void zero16(f32x16& a) {
#pragma unroll
  for (int i = 0; i < 16; ++i) a[i] = 0.f;
}

struct NoHook { DEV void operator()(int) const {} };
template <int BN, typename HOOK = NoHook>
DEV void gemm_core(f32x16 (&acc)[2][BN / 64], const bf16* __restrict__ A, int lda, const bf16* __restrict__ Bt,
                   int ldb, int nvalid, int K, char* lds, HOOK hook = NoHook()) {
  constexpr int NB = BN / 32;
  constexpr int WN = BN / 2;
  constexpr int STAGE = (128 + BN) * 128;
  const int tid = ltid(), lane = tid & 63, w = tid >> 6, wm = w >> 1, wn = w & 1, ll = lane & 31, hh = lane >> 5;
  const int lrow = tid >> 3, lch = (tid & 7) ^ ((tid >> 4) & 7);
  const bf16* abase = A + (size_t)lrow * lda + lch * 8;
  const bf16* bptr[NB];
#pragma unroll
  for (int i = 0; i < NB; ++i) { int r = lrow + 32 * i; r = r < nvalid ? r : nvalid - 1; bptr[i] = Bt + (size_t)r * ldb + lch * 8; }
  char* ldst = lds + tid * 16;
  const int key = (ll >> 1) & 7;
  int koff[4];
#pragma unroll
  for (int ks = 0; ks < 4; ++ks) koff[ks] = ((2 * ks + hh) ^ key) * 16;
  __syncthreads();
#pragma unroll
  for (int i = 0; i < 4; ++i)
    __builtin_amdgcn_global_load_lds((const unsigned*)(abase + (size_t)(32 * i) * lda), (__attribute__((address_space(3))) unsigned*)(ldst + i * 4096), 16, 0, 0);
#pragma unroll
  for (int i = 0; i < NB; ++i)
    __builtin_amdgcn_global_load_lds((const unsigned*)(bptr[i]), (__attribute__((address_space(3))) unsigned*)(ldst + 16384 + i * 4096), 16, 0, 0);
  asm volatile("s_waitcnt vmcnt(0)" ::: "memory");
  __syncthreads();
  const int nk = K >> 6;
  for (int kt = 0; kt < nk; ++kt) {
    if (kt + 1 < nk) {
      char* d = ldst + ((kt + 1) & 1) * STAGE;
#pragma unroll
      for (int i = 0; i < 4; ++i)
        __builtin_amdgcn_global_load_lds((const unsigned*)(abase + (size_t)(32 * i) * lda + (kt + 1) * 64), (__attribute__((address_space(3))) unsigned*)(d + i * 4096), 16, 0, 0);
#pragma unroll
      for (int i = 0; i < NB; ++i)
        __builtin_amdgcn_global_load_lds((const unsigned*)(bptr[i] + (kt + 1) * 64), (__attribute__((address_space(3))) unsigned*)(d + 16384 + i * 4096), 16, 0, 0);
    }
    const char* s = lds + (kt & 1) * STAGE;
    const char* sa = s + (wm * 64 + ll) * 128;
    const char* sb = s + 16384 + (wn * WN + ll) * 128;
#pragma unroll
    for (int ks = 0; ks < 4; ++ks) {
      bf16x8 a0 = *(const bf16x8*)(sa + koff[ks]), a1 = *(const bf16x8*)(sa + 32 * 128 + koff[ks]);
#pragma unroll
      for (int ni = 0; ni < BN / 64; ++ni) {
        bf16x8 b = *(const bf16x8*)(sb + ni * 32 * 128 + koff[ks]);
        acc[0][ni] = MFMA(a0, b, acc[0][ni]);
        acc[1][ni] = MFMA(a1, b, acc[1][ni]);
      }
    }
    hook(kt);
    asm volatile("s_waitcnt vmcnt(0)" ::: "memory");
    __syncthreads();
  }
}

DEV void tr_tile(const float* __restrict__ src, bf16* __restrict__ dst, int K, int N, int kt, int nt, char* lds, int dstK = 0) {
  if (dstK == 0) dstK = K;
  float* t = (float*)lds;
  const int tid = ltid();
  __syncthreads();
#pragma unroll
  for (int i = 0; i < 4; ++i) {
    int k = (tid >> 4) + 16 * i, n4 = (tid & 15) * 4;
    float4 v = *(const float4*)(src + (size_t)(kt * 64 + k) * N + nt * 64 + n4);
    t[k * 65 + n4] = v.x; t[k * 65 + n4 + 1] = v.y; t[k * 65 + n4 + 2] = v.z; t[k * 65 + n4 + 3] = v.w;
  }
  __syncthreads();
  const int n = tid >> 2, k0 = (tid & 3) * 16;
  uint4 o0, o1;
  o0.x = pack2(t[(k0 + 0) * 65 + n], t[(k0 + 1) * 65 + n]); o0.y = pack2(t[(k0 + 2) * 65 + n], t[(k0 + 3) * 65 + n]);
  o0.z = pack2(t[(k0 + 4) * 65 + n], t[(k0 + 5) * 65 + n]); o0.w = pack2(t[(k0 + 6) * 65 + n], t[(k0 + 7) * 65 + n]);
  o1.x = pack2(t[(k0 + 8) * 65 + n], t[(k0 + 9) * 65 + n]); o1.y = pack2(t[(k0 + 10) * 65 + n], t[(k0 + 11) * 65 + n]);
  o1.z = pack2(t[(k0 + 12) * 65 + n], t[(k0 + 13) * 65 + n]); o1.w = pack2(t[(k0 + 14) * 65 + n], t[(k0 + 15) * 65 + n]);
  bf16* d = dst + (size_t)(nt * 64 + n) * dstK + kt * 64 + k0;
  *(uint4*)d = o0; *(uint4*)(d + 8) = o1;
}

DEV void mod_job(const P& p, int l, int cb, char* lds) {
  float* sc = (float*)lds;
  float* red = sc + 9 * 1024;
  const int tid = ltid();
  __syncthreads();
  for (int i = tid; i < 9 * 1024; i += 256) {
    int c = i >> 10, k = i & 1023;
    float v = c == 0 ? p.c_ctx[k] : p.c[(c - 1) * 1024 + k];
    sc[i] = silu(v);
  }
  __syncthreads();
  const int col = cb * 64 + (tid & 63), kq = tid >> 6;
  float a[9];
#pragma unroll
  for (int c = 0; c < 9; ++c) a[c] = 0.f;
  const float* wp = p.w_ada + ((size_t)l * 1024 + kq * 256) * 3072 + col;
#pragma unroll 8
  for (int k = 0; k < 256; ++k) {
    float wv = wp[(size_t)k * 3072];
#pragma unroll
    for (int c = 0; c < 9; ++c) a[c] += sc[c * 1024 + kq * 256 + k] * wv;
  }
#pragma unroll
  for (int c = 0; c < 9; ++c) red[(kq * 9 + c) * 64 + (tid & 63)] = a[c];
  __syncthreads();
  float* mod = (float*)(p.ws + W_MOD);
  for (int i = tid; i < 9 * 64; i += 256) {
    int c = i >> 6, j = i & 63;
    float s = red[(0 * 9 + c) * 64 + j] + red[(1 * 9 + c) * 64 + j] + red[(2 * 9 + c) * 64 + j] + red[(3 * 9 + c) * 64 + j];
    mod[(size_t)(l * 9 + c) * 3072 + cb * 64 + j] = s + p.b_ada[l * 3072 + cb * 64 + j];
  }
}

DEV void cache_job(const P& p, int job, char* lds) {
  const int tid = ltid();
  const int bl = job >> 3, h = job & 7;
  bf16* CK = (bf16*)(p.ws + W_CK) + (size_t)job * 256 * 64;
  bf16* CV = (bf16*)(p.ws + W_CVT) + (size_t)job * 64 * 256;
  const float* ks = p.cache_na_k + (size_t)bl * 256 * 512 + h * 64;
  const float* vs = p.cache_na_v + (size_t)bl * 256 * 512 + h * 64;
  float* t = (float*)lds;
  __syncthreads();
  for (int i = tid; i < 256 * 16; i += 256) {
    int r = i >> 4, c4 = (i & 15) * 4;
    float4 kv = *(const float4*)(ks + (size_t)r * 512 + c4);
    uint2 o; o.x = pack2(kv.x, kv.y); o.y = pack2(kv.z, kv.w);
    *(uint2*)(CK + r * 64 + c4) = o;
    float4 vv = *(const float4*)(vs + (size_t)r * 512 + c4);
    t[r * 65 + c4] = vv.x; t[r * 65 + c4 + 1] = vv.y; t[r * 65 + c4 + 2] = vv.z; t[r * 65 + c4 + 3] = vv.w;
  }
  __syncthreads();
  for (int i = tid; i < 64 * 64; i += 256) {
    int e = i >> 6, t4 = (i & 63) * 4;
    uint2 o; o.x = pack2(t[(t4)*65 + e], t[(t4 + 1) * 65 + e]); o.y = pack2(t[(t4 + 2) * 65 + e], t[(t4 + 3) * 65 + e]);
    *(uint2*)(CV + e * 256 + t4) = o;
  }
}

DEV void h_job(const P& p, int l, int g0, int tb) {
  const int tid_ = ltid(); const int lane = tid_ & 63, w = tid_ >> 6;
  bf16* H = (bf16*)(p.ws + W_H);
  const float* mod = (const float*)(p.ws + W_MOD);
#pragma unroll
  for (int i = 0; i < 4; ++i) {
    int tl = tb * 16 + w * 4 + i, g = g0 + tl, cond = g >> 12;
    const float* x = xin_row(p, g);
    const float* md = mod + (size_t)(l * 9 + cond) * 3072;
#pragma unroll
    for (int j = 0; j < 4; ++j) {
      int col = lane * 4 + 256 * j;
      float4 xv = *(const float4*)(x + col), sh = *(const float4*)(md + col), sc = *(const float4*)(md + 1024 + col);
      uint2 o; o.x = pack2(xv.x * (1.f + sc.x) + sh.x, xv.y * (1.f + sc.y) + sh.y);
      o.y = pack2(xv.z * (1.f + sc.z) + sh.z, xv.w * (1.f + sc.w) + sh.w);
      *(uint2*)(H + (size_t)tl * 1024 + col) = o;
    }
  }
}

DEV void ln_job(const P& p, int l, int g0, int tb) {
  const int tid_ = ltid(); const int lane = tid_ & 63, w = tid_ >> 6;
  bf16* H = (bf16*)(p.ws + W_H);
  const float* mod = (const float*)(p.ws + W_MOD);
#pragma unroll
  for (int i = 0; i < 4; ++i) {
    int tl = tb * 16 + w * 4 + i, g = g0 + tl, cond = g >> 12;
    float* y = p.out + (size_t)g * 1024;
    float4 v[4];
    float s = 0.f;
#pragma unroll
    for (int j = 0; j < 4; ++j) { v[j] = *(const float4*)(y + lane * 4 + 256 * j); s += v[j].x + v[j].y + v[j].z + v[j].w; }
#pragma unroll
    for (int o = 32; o > 0; o >>= 1) s += __shfl_xor(s, o);
    float mu = s * (1.f / 1024.f), q = 0.f;
#pragma unroll
    for (int j = 0; j < 4; ++j) {
      v[j].x -= mu; v[j].y -= mu; v[j].z -= mu; v[j].w -= mu;
      q += v[j].x * v[j].x + v[j].y * v[j].y + v[j].z * v[j].z + v[j].w * v[j].w;
    }
#pragma unroll
    for (int o = 32; o > 0; o >>= 1) q += __shfl_xor(q, o);
    float rs = rsqrtf(q * (1.f / 1024.f) + EPS);
    const float* md = mod + (size_t)((l + 1) * 9 + cond) * 3072;
#pragma unroll
    for (int j = 0; j < 4; ++j) {
      int col = lane * 4 + 256 * j;
      float4 gg = *(const float4*)(p.ln_g + l * 1024 + col), bb = *(const float4*)(p.ln_b + l * 1024 + col);
      float4 o;
      o.x = v[j].x * rs * gg.x + bb.x; o.y = v[j].y * rs * gg.y + bb.y;
      o.z = v[j].z * rs * gg.z + bb.z; o.w = v[j].w * rs * gg.w + bb.w;
      if (l == 1) {
        typedef float nt_f32x4 __attribute__((ext_vector_type(4)));
        nt_f32x4 t4 = {o.x, o.y, o.z, o.w};
        __builtin_nontemporal_store(t4, (nt_f32x4*)(y + col));
      } else {
        *(float4*)(y + col) = o;
      }
      if (l == 0) {
        float4 sh = *(const float4*)(md + col), sc = *(const float4*)(md + 1024 + col);
        uint2 hb; hb.x = pack2(o.x * (1.f + sc.x) + sh.x, o.y * (1.f + sc.y) + sh.y);
        hb.y = pack2(o.z * (1.f + sc.z) + sh.z, o.w * (1.f + sc.w) + sh.w);
        *(uint2*)(H + (size_t)tl * 1024 + col) = hb;
      }
    }
  }
}

DEV float rope_inv(int i) { return ex2(-(float)(i & 15) * (13.287712379549449f / 16.f)); }

DEV void mlaprep_job(const P& p, int l, int g0, int tb) {
  const int tid_ = ltid(); const int lane = tid_ & 63, w = tid_ >> 6;
  const bf16* Z = (const bf16*)(p.ws + W_Z);
  const float* KVPE = (const float*)(p.ws + W_KVPE);
  bf16* QN = (bf16*)(p.ws + W_QN);
  bf16* CKVB = (bf16*)(p.ws + W_CKVB);
  bf16* KPER = (bf16*)(p.ws + W_KPER);
  for (int i = 0; i < 8; ++i) {
    int tl = tb * 32 + w * 8 + i, g = g0 + tl, ug = tl >> 12, tu = tl & 4095;
    bool isctx = g < UT;
    uint2 qr = *(const uint2*)(Z + (size_t)tl * ZS + C_QD + lane * 4);
    float q0 = bf2f(qr.x & 0xffff), q1 = bf2f(qr.x >> 16), q2 = bf2f(qr.y & 0xffff), q3 = bf2f(qr.y >> 16);
    float ss = q0 * q0 + q1 * q1 + q2 * q2 + q3 * q3;
#pragma unroll
    for (int o = 32; o > 0; o >>= 1) ss += __shfl_xor(ss, o);
    float r = rsqrtf(ss * (1.f / 256.f) + EPS);
    float4 gq = *(const float4*)(p.qnorm_g + l * 256 + lane * 4);
    uint2 qo; qo.x = pack2(q0 * r * gq.x, q1 * r * gq.y); qo.y = pack2(q2 * r * gq.z, q3 * r * gq.w);
    *(uint2*)(QN + (size_t)tl * 256 + lane * 4) = qo;
    float2 kv = *(const float2*)(KVPE + (size_t)tl * 192 + lane * 2);
    float s2 = kv.x * kv.x + kv.y * kv.y;
#pragma unroll
    for (int o = 32; o > 0; o >>= 1) s2 += __shfl_xor(s2, o);
    float r2 = rsqrtf(s2 * (1.f / 128.f) + EPS);
    float2 gk = *(const float2*)(p.kvnorm_g + l * 128 + lane * 2);
    float c0 = kv.x * r2 * gk.x, c1 = kv.y * r2 * gk.y;
    *(unsigned*)(CKVB + ((size_t)ug * KVR + tu) * 128 + lane * 2) = pack2(c0, c1);
    if (isctx) {
      int b = g >> 8, t = g & 255;
      *(float2*)(p.out + O_CKV + ((size_t)(b * 2 + l) * 256 + t) * 128 + lane * 2) = make_float2(c0, c1);
    }
    float kp = KVPE[(size_t)tl * 192 + 128 + lane];
    float other = __shfl_xor(kp, 32);
    float ko = kp;
    if (!isctx) {
      int ii = lane & 31;
      float pos = ii < 16 ? (float)(tu >> 6) : (float)(tu & 63);
      float ang = pos * rope_inv(ii);
      float sn, cs;
      sincosf(ang, &sn, &cs);
      ko = lane < 32 ? kp * cs - other * sn : other * sn + kp * cs;
    }
    KPER[((size_t)ug * KVR + tu) * 64 + lane] = f2bf(ko);
  }
}

DEV void mlatail_job(const P& p, int l, int g0, int ug, int rb) {
  const int tid = ltid();
  const int b = ((g0 >> 12) + ug) - 1;
  bf16* CKVB = (bf16*)(p.ws + W_CKVB);
  bf16* KPER = (bf16*)(p.ws + W_KPER);
  for (int i = tid; i < 32 * 128; i += 256) {
    int r = rb * 32 + (i >> 7), c = i & 127;
    CKVB[((size_t)ug * KVR + UT + r) * 128 + c] = f2bf(p.cache_ckv[((size_t)(b * 2 + l) * 256 + r) * 128 + c]);
  }
  for (int i = tid; i < 32 * 64; i += 256) {
    int r = rb * 32 + (i >> 6), c = i & 63;
    KPER[((size_t)ug * KVR + UT + r) * 64 + c] = f2bf(p.cache_kpe[((size_t)(b * 2 + l) * 256 + r) * 64 + c]);
  }
}

DEV void conv_job(const P& p, int l, int g0, int tb) {
  const int tid = ltid();
  const bf16* Z = (const bf16*)(p.ws + W_Z);
  bf16* BR = (bf16*)(p.ws + W_BR);
  const int t0 = tb * 32, g = g0 + t0;
  const int L = g < UT ? 256 : 4096;
  const int pos0 = g & (L - 1);
  const int c = tid * 2;
  float2 w0 = *(const float2*)(p.conv_w + (l * 3 + 0) * 512 + c), w1 = *(const float2*)(p.conv_w + (l * 3 + 1) * 512 + c),
         w2 = *(const float2*)(p.conv_w + (l * 3 + 2) * 512 + c);
  auto ld2 = [&](int tl, int col) { unsigned u = *(const unsigned*)(Z + (size_t)tl * ZS + col + c); return make_float2(bf2f(u & 0xffff), bf2f(u >> 16)); };
  auto uu = [&](int tl) { float2 a = ld2(tl, C_DC), b = ld2(tl, C_DX); return make_float2(a.x * b.x, a.y * b.y); };
  float2 up = pos0 > 0 ? uu(t0 - 1) : make_float2(0.f, 0.f);
  float2 uc = uu(t0);
  for (int i = 0; i < 32; ++i) {
    int tl = t0 + i;
    float2 un = (pos0 + i < L - 1) ? uu(tl + 1) : make_float2(0.f, 0.f);
    float2 bb = ld2(tl, C_DB), gg = ld2(tl, C_DG);
    float o0 = bb.x * (w0.x * up.x + w1.x * uc.x + w2.x * un.x) * gg.x;
    float o1 = bb.y * (w0.y * up.y + w1.y * uc.y + w2.y * un.y) * gg.y;
    *(unsigned*)(BR + (size_t)tl * 2048 + 1536 + c) = pack2(o0, o1);
    up = uc; uc = un;
  }
}

DEV void stage_acc(const f32x16 (&acc)[2][2], char* lds) {
  const int tid_ = ltid(); const int lane = tid_ & 63, w = tid_ >> 6, wm = w >> 1, wn = w & 1, ll = lane & 31, hh = lane >> 5;
  float* t = (float*)lds;
#pragma unroll
  for (int mi = 0; mi < 2; ++mi)
#pragma unroll
    for (int ni = 0; ni < 2; ++ni)
#pragma unroll
      for (int reg = 0; reg < 16; ++reg)
        t[(wm * 64 + mi * 32 + rowoff(reg, hh)) * 132 + wn * 64 + ni * 32 + ll] = acc[mi][ni][reg];
  __syncthreads();
}
DEV uint4 pack8(const float* v) {
  uint4 u; u.x = pack2(v[0], v[1]); u.y = pack2(v[2], v[3]); u.z = pack2(v[4], v[5]); u.w = pack2(v[6], v[7]);
  return u;
}

DEV void gemm1_job(const P& p, int l, int g0, int mt, int n0, int ncap, char* lds) {
  const int tid = ltid();
  const int m0 = mt * 128;
  {
    f32x16 acc[2][2];
    zero16(acc[0][0]); zero16(acc[0][1]); zero16(acc[1][0]); zero16(acc[1][1]);
    const bf16* A = (const bf16*)(p.ws + W_H) + (size_t)m0 * 1024;
    const bf16* Bt = (const bf16*)(p.ws + W_WIN) + ((size_t)l * ZW + n0) * 1024;
    gemm_core<128>(acc, A, 1024, Bt, 1024, ncap - n0 < 128 ? ncap - n0 : 128, 1024, lds);
    stage_acc(acc, lds);
  }
  const float* t = (const float*)lds;
  bf16* Z = (bf16*)(p.ws + W_Z);
  const bool isctx = (g0 + m0) < UT;
  const int cc = (tid & 15) * 8, cb = n0 + cc;
  if (cb < ncap) {
    int mode;
    if (cb < C_AFF) mode = 1; else if (cb < C_AFB) mode = 3; else if (cb < C_AI) mode = 4; else if (cb < C_AG) mode = 0;
    else if (cb < C_BQ) mode = 1; else if (cb < C_BK) mode = 5; else if (cb < C_BV) mode = 6; else if (cb < C_BG) mode = 7;
    else if (cb < C_QD) mode = 1; else if (cb < C_KVD) mode = 0; else if (cb < C_KPE) mode = 8; else if (cb < C_CG) mode = 9;
    else if (cb < C_DB) mode = 1; else if (cb < C_DG) mode = 0; else if (cb < C_MG) mode = 1; else mode = 2;
    float bias[8], lbv[8];
#pragma unroll
    for (int j = 0; j < 8; ++j) { bias[j] = p.b_in[l * ZW + cb + j]; lbv[j] = 0.f; }
    if ((mode == 3 || mode == 4) && l > 0) {
      int dir = mode - 3, c = cb - (dir ? C_AFB : C_AFF);
#pragma unroll
      for (int j = 0; j < 8; ++j) lbv[j] = sigm(p.lb_logits[(dir * 2 + 1) * 512 + c + j] - p.lb_logits[(dir * 2 + 0) * 512 + c + j]);
    }
#pragma unroll 1
    for (int it = 0; it < 8; ++it) {
      const int rl = it * 16 + (tid >> 4), row = m0 + rl, g = g0 + row;
      float v[8];
      {
        float4 a0 = *(const float4*)(t + rl * 132 + cc), a1 = *(const float4*)(t + rl * 132 + cc + 4);
        v[0] = a0.x + bias[0]; v[1] = a0.y + bias[1]; v[2] = a0.z + bias[2]; v[3] = a0.w + bias[3];
        v[4] = a1.x + bias[4]; v[5] = a1.y + bias[5]; v[6] = a1.z + bias[6]; v[7] = a1.w + bias[7];
      }
      const size_t octx = (size_t)((g >> 8) * 2 + l) * 256 + (g & 255);
      switch (mode) {
        case 0: *(uint4*)(Z + (size_t)row * ZS + cb) = pack8(v); break;
        case 1: {
#pragma unroll
          for (int j = 0; j < 8; ++j) v[j] = silu(v[j]);
          *(uint4*)(Z + (size_t)row * ZS + cb) = pack8(v);
        } break;
        case 2: break;
        case 3:
        case 4: {
#pragma unroll
          for (int j = 0; j < 8; ++j)
            v[j] = (lbv[j] == 0.f) ? (fminf(v[j], 0.f) - __logf(1.f + __expf(-fabsf(v[j])))) : __logf(lbv[j] + (1.f - lbv[j]) * sigm(v[j]));
          _Float16* L = (_Float16*)(p.ws + (mode == 3 ? W_LGF : W_LGB)) + (size_t)row * 512 + (cb - (mode == 3 ? C_AFF : C_AFB));
          typedef _Float16 h8 __attribute__((ext_vector_type(8)));
          h8 hv;
#pragma unroll
          for (int j = 0; j < 8; ++j) hv[j] = (_Float16)v[j];
          *(h8*)L = hv;
        } break;
        case 5: {
#pragma unroll
          for (int j = 0; j < 8; ++j) v[j] *= QS_NA;
          *(uint4*)(Z + (size_t)row * ZS + cb) = pack8(v);
        } break;
        case 6:
        case 7: {
          if (mode == 6) *(uint4*)(Z + (size_t)row * ZS + cb) = pack8(v);
          if (isctx) {
            float* o = p.out + (mode == 6 ? O_NK : O_NV) + octx * 512 + (cb - (mode == 6 ? C_BK : C_BV));
            *(float4*)o = make_float4(v[0], v[1], v[2], v[3]);
            *(float4*)(o + 4) = make_float4(v[4], v[5], v[6], v[7]);
          }
        } break;
        case 8: {
          float* o = (float*)(p.ws + W_KVPE) + (size_t)row * 192 + (cb - C_KVD);
          *(float4*)o = make_float4(v[0], v[1], v[2], v[3]);
          *(float4*)(o + 4) = make_float4(v[4], v[5], v[6], v[7]);
        } break;
        case 9: {
          float* o = (float*)(p.ws + W_KVPE) + (size_t)row * 192 + 128 + (cb - C_KPE);
          *(float4*)o = make_float4(v[0], v[1], v[2], v[3]);
          *(float4*)(o + 4) = make_float4(v[4], v[5], v[6], v[7]);
          if (isctx) {
            float* o2 = p.out + O_KPE + octx * 64 + (cb - C_KPE);
            *(float4*)o2 = make_float4(v[0], v[1], v[2], v[3]);
            *(float4*)(o2 + 4) = make_float4(v[4], v[5], v[6], v[7]);
          }
        } break;
      }
    }
  }
  if (n0 >= C_MG) {
    bf16* GTt = (bf16*)(p.ws + W_G);
    const int c = tid & 127, rb = tid >> 7;
    const float bs = p.b_in[l * ZW + n0 + c];
#pragma unroll 1
    for (int i = 0; i < 8; ++i) {
      float v[8];
#pragma unroll
      for (int j = 0; j < 8; ++j) v[j] = sigm(t[(rb * 64 + i * 8 + j) * 132 + c] + bs);
      *(uint4*)(GTt + (size_t)(n0 - C_MG + c) * GT + m0 + rb * 64 + i * 8) = pack8(v);
    }
  }
  if (n0 >= C_BV && n0 < C_BG) {
    bf16* NVT = (bf16*)(p.ws + W_NVT);
    const int c = tid & 127, rb = tid >> 7;
    const float bs = p.b_in[l * ZW + n0 + c];
#pragma unroll 1
    for (int i = 0; i < 8; ++i) {
      float v[8];
#pragma unroll
      for (int j = 0; j < 8; ++j) v[j] = t[(rb * 64 + i * 8 + j) * 132 + c] + bs;
      *(uint4*)(NVT + (size_t)(n0 - C_BV + c) * GT + m0 + rb * 64 + i * 8) = pack8(v);
    }
  }
}

DEV void gemmq_job(const P& p, int l, int g0, int mt, int nt, char* lds) {
  const int tid_ = ltid(); const int lane = tid_ & 63, w = tid_ >> 6, wm = w >> 1, wn = w & 1, ll = lane & 31, hh = lane >> 5;
  f32x16 acc[2][2];
  zero16(acc[0][0]); zero16(acc[0][1]); zero16(acc[1][0]); zero16(acc[1][1]);
  const int m0 = mt * 128, n0 = nt * 128;
  gemm_core<128>(acc, (const bf16*)(p.ws + W_QN) + (size_t)m0 * 256, 256,
                 (const bf16*)(p.ws + W_WQB) + ((size_t)l * 768 + n0) * 256, 256, 128, 256, lds);
  bf16* QM = (bf16*)(p.ws + W_QM);
  const bool isctx = (g0 + m0) < UT;
  const int cbase = n0 + wn * 64;
  const bool rope = (!isctx) && ((cbase % 192) == 128);
  const float inv = rope_inv(ll);
#pragma unroll
  for (int mi = 0; mi < 2; ++mi) {
#pragma unroll
    for (int reg = 0; reg < 16; ++reg) {
      const int row = m0 + wm * 64 + mi * 32 + rowoff(reg, hh);
      float x1 = acc[mi][0][reg] * QS_MLA, x2 = acc[mi][1][reg] * QS_MLA;
      if (rope) {
        int tu = row & 4095;
        float pos = ll < 16 ? (float)(tu >> 6) : (float)(tu & 63);
        float sn, cs;
        sincosf(pos * inv, &sn, &cs);
        float y1 = x1 * cs - x2 * sn, y2 = x1 * sn + x2 * cs;
        x1 = y1; x2 = y2;
      }
      QM[(size_t)row * 768 + cbase + ll] = f2bf(x1);
      QM[(size_t)row * 768 + cbase + 32 + ll] = f2bf(x2);
    }
  }
}

DEV void gemmkv_job(const P& p, int l, int ug, int mt, int nt, char* lds) {
  const int tid_ = ltid(); const int lane = tid_ & 63, w = tid_ >> 6, wm = w >> 1, wn = w & 1, ll = lane & 31, hh = lane >> 5;
  f32x16 acc[2][2];
  zero16(acc[0][0]); zero16(acc[0][1]); zero16(acc[1][0]); zero16(acc[1][1]);
  const int m0 = mt * 128, n0 = nt * 128;
  gemm_core<128>(acc, (const bf16*)(p.ws + W_CKVB) + ((size_t)ug * KVR + m0) * 128, 128,
                 (const bf16*)(p.ws + W_WKVB) + ((size_t)l * 1024 + n0) * 128, 128, 128, 128, lds);
  bf16* KN = (bf16*)(p.ws + W_KN);
  bf16* VT = (bf16*)(p.ws + W_VT);
  const int hd = n0 >> 8;
  const bool isv = (n0 & 255) != 0;
#pragma unroll
  for (int mi = 0; mi < 2; ++mi)
#pragma unroll
    for (int ni = 0; ni < 2; ++ni) {
      const int cw = wn * 64 + ni * 32 + ll;
      const int rbase = m0 + wm * 64 + mi * 32;
      if (!isv) {
#pragma unroll
        for (int reg = 0; reg < 16; ++reg)
          KN[((size_t)ug * KVR + rbase + rowoff(reg, hh)) * 512 + hd * 128 + cw] = f2bf(acc[mi][ni][reg]);
      } else {
#pragma unroll
        for (int g4 = 0; g4 < 4; ++g4) {
          uint2 o; o.x = pack2(acc[mi][ni][4 * g4], acc[mi][ni][4 * g4 + 1]); o.y = pack2(acc[mi][ni][4 * g4 + 2], acc[mi][ni][4 * g4 + 3]);
          *(uint2*)(VT + ((size_t)ug * 512 + hd * 128 + cw) * KVR + rbase + 8 * g4 + 4 * hh) = o;
        }
      }
    }
}

DEV void gemm3_job(const P& p, int l, int mt, int nt, char* lds) {
  constexpr int STAGE = 256 * 128;
  const int tid = ltid(), lane = tid & 63, w = tid >> 6, wm = w >> 1, wn = w & 1, ll = lane & 31, hh = lane >> 5;
  const int m0 = mt * 128, n0 = nt * 128;
  f32x16 ms[2][2], acc[2][2];
  unsigned gp[2][2][8];
#pragma unroll
  for (int mi = 0; mi < 2; ++mi)
#pragma unroll
    for (int ni = 0; ni < 2; ++ni) { zero16(ms[mi][ni]); zero16(acc[mi][ni]); }
  const int lrow = tid >> 3, lch = (tid & 7) ^ ((tid >> 4) & 7);
  const bf16* aH = (const bf16*)(p.ws + W_H) + (size_t)(m0 + lrow) * 1024 + lch * 8;
  const bf16* aB = (const bf16*)(p.ws + W_BR) + (size_t)(m0 + lrow) * 2048 + lch * 8;
  const bf16* bG = (const bf16*)(p.ws + W_WIN) + ((size_t)l * ZW + C_MG + n0 + lrow) * 1024 + lch * 8;
  const bf16* bB = (const bf16*)(p.ws + W_WBR) + ((size_t)l * 1024 + n0 + lrow) * 2048 + lch * 8;
  char* ldst = lds + tid * 16;
  auto issue = [&](int kt, int st) {
    const int n = kt / 24, r = kt - n * 24;
    char* d = ldst + st * STAGE;
    if (r < 16) {
      const bf16* ap = aH + r * 64;
      const bf16* bp = bG + (size_t)n * 1024 * 1024 + r * 64;
#pragma unroll
      for (int i = 0; i < 4; ++i)
        __builtin_amdgcn_global_load_lds((const unsigned*)(ap + (size_t)(32 * i) * 1024), (__attribute__((address_space(3))) unsigned*)(d + i * 4096), 16, 0, 0);
#pragma unroll
      for (int i = 0; i < 4; ++i)
        __builtin_amdgcn_global_load_lds((const unsigned*)(bp + (size_t)(32 * i) * 1024), (__attribute__((address_space(3))) unsigned*)(d + 16384 + i * 4096), 16, 0, 0);
    } else {
      const bf16* ap = aB + n * 512 + (r - 16) * 64;
      const bf16* bp = bB + n * 512 + (r - 16) * 64;
#pragma unroll
      for (int i = 0; i < 4; ++i)
        __builtin_amdgcn_global_load_lds((const unsigned*)(ap + (size_t)(32 * i) * 2048), (__attribute__((address_space(3))) unsigned*)(d + i * 4096), 16, 0, 0);
#pragma unroll
      for (int i = 0; i < 4; ++i)
        __builtin_amdgcn_global_load_lds((const unsigned*)(bp + (size_t)(32 * i) * 2048), (__attribute__((address_space(3))) unsigned*)(d + 16384 + i * 4096), 16, 0, 0);
    }
  };
  const int key = (ll >> 1) & 7;
  int koff[4];
#pragma unroll
  for (int ks = 0; ks < 4; ++ks) koff[ks] = ((2 * ks + hh) ^ key) * 16;
  __syncthreads();
  issue(0, 0);
  asm volatile("s_waitcnt vmcnt(0)" ::: "memory");
  __syncthreads();
  int kt = 0;
  auto step = [&]() {
    if (kt + 1 < 96) issue(kt + 1, (kt + 1) & 1);
    const char* s = lds + (kt & 1) * STAGE;
    const char* sa = s + (wm * 64 + ll) * 128;
    const char* sb = s + 16384 + (wn * 64 + ll) * 128;
#pragma unroll
    for (int ks = 0; ks < 4; ++ks) {
      bf16x8 a0 = *(const bf16x8*)(sa + koff[ks]), a1 = *(const bf16x8*)(sa + 32 * 128 + koff[ks]);
#pragma unroll
      for (int ni = 0; ni < 2; ++ni) {
        bf16x8 bq = *(const bf16x8*)(sb + ni * 32 * 128 + koff[ks]);
        acc[0][ni] = MFMA(a0, bq, acc[0][ni]);
        acc[1][ni] = MFMA(a1, bq, acc[1][ni]);
      }
    }
    asm volatile("s_waitcnt vmcnt(0)" ::: "memory");
    __syncthreads();
    ++kt;
  };
#pragma unroll 1
  for (int n = 0; n < 4; ++n) {
#pragma unroll 1
    for (int r = 0; r < 16; ++r) step();
#pragma unroll
    for (int ni = 0; ni < 2; ++ni) {
      const float bias = p.b_in[l * ZW + C_MG + n * 1024 + n0 + wn * 64 + ni * 32 + ll];
#pragma unroll
      for (int mi = 0; mi < 2; ++mi)
#pragma unroll
        for (int k = 0; k < 8; ++k) {
          gp[mi][ni][k] = pack2(sigm(acc[mi][ni][2 * k] + bias), sigm(acc[mi][ni][2 * k + 1] + bias));
          acc[mi][ni][2 * k] = 0.f; acc[mi][ni][2 * k + 1] = 0.f;
        }
    }
#pragma unroll 1
    for (int r = 0; r < 8; ++r) step();
#pragma unroll
    for (int mi = 0; mi < 2; ++mi)
#pragma unroll
      for (int ni = 0; ni < 2; ++ni)
#pragma unroll
        for (int k = 0; k < 8; ++k) {
          ms[mi][ni][2 * k] += bf2f(gp[mi][ni][k] & 0xffff) * acc[mi][ni][2 * k];
          ms[mi][ni][2 * k + 1] += bf2f(gp[mi][ni][k] >> 16) * acc[mi][ni][2 * k + 1];
          acc[mi][ni][2 * k] = 0.f; acc[mi][ni][2 * k + 1] = 0.f;
        }
  }
  bf16* MB = (bf16*)(p.ws + W_MB);
  stage_acc(ms, lds);
  {
    const float* t = (const float*)lds;
    const int cc = (tid & 15) * 8;
#pragma unroll 1
    for (int it = 0; it < 8; ++it) {
      const int rl = it * 16 + (tid >> 4);
      float v[8];
      float4 a0 = *(const float4*)(t + rl * 132 + cc), a1 = *(const float4*)(t + rl * 132 + cc + 4);
      v[0] = a0.x; v[1] = a0.y; v[2] = a0.z; v[3] = a0.w; v[4] = a1.x; v[5] = a1.y; v[6] = a1.z; v[7] = a1.w;
      *(uint4*)(MB + (size_t)(m0 + rl) * 1024 + n0 + cc) = pack8(v);
    }
  }
}

DEV void gemm4_job(const P& p, int l, int g0, int mt, int nt, char* lds) {
  const int tid = ltid();
  const int m0 = mt * 128, n0 = nt * 128;
  {
    f32x16 acc[2][2];
    zero16(acc[0][0]); zero16(acc[0][1]); zero16(acc[1][0]); zero16(acc[1][1]);
    gemm_core<128>(acc, (const bf16*)(p.ws + W_MB) + (size_t)m0 * 1024, 1024,
                   (const bf16*)(p.ws + W_WOUT) + ((size_t)l * 1024 + n0) * 1024, 1024, 128, 1024, lds);
    stage_acc(acc, lds);
  }
  const float* t = (const float*)lds;
  const int cond = (g0 + m0) >> 12;
  const int cc = (tid & 31) * 4;
  const float4 gt = *(const float4*)((const float*)(p.ws + W_MOD) + (size_t)(l * 9 + cond) * 3072 + 2048 + n0 + cc);
#pragma unroll 1
  for (int it = 0; it < 16; ++it) {
    const int rl = it * 8 + (tid >> 5), g = g0 + m0 + rl;
    float* y = p.out + (size_t)g * 1024 + n0 + cc;
    const float4 xv = l == 0 ? *(const float4*)(xin_row(p, g) + n0 + cc) : *(const float4*)y;
    const float4 a = *(const float4*)(t + rl * 132 + cc);
    *(float4*)y = make_float4(ALPHA * xv.x + gt.x * a.x, ALPHA * xv.y + gt.y * a.y, ALPHA * xv.z + gt.z * a.z, ALPHA * xv.w + gt.w * a.w);
  }
}

template <int ET>
DEV void smax32(f32x16& x, float& m, float& lsum, f32x16 (&o)[ET]) {
  float mx = x[0];
#pragma unroll
  for (int i = 1; i < 16; ++i) mx = fmaxf(mx, x[i]);
  mx = xhalf_max(mx);
  if (__any(mx > m + 8.f)) {
    float mn = fmaxf(m, mx), al_ = ex2(m - mn);
    m = mn;
    lsum *= al_;
#pragma unroll
    for (int e = 0; e < ET; ++e)
#pragma unroll
      for (int i = 0; i < 16; ++i) o[e][i] *= al_;
  }
  float ps = 0.f;
#pragma unroll
  for (int i = 0; i < 16; ++i) { x[i] = ex2(x[i] - m); ps += x[i]; }
  lsum += ps;
}

DEV void na_wave(const P& p, int l, int g0, int ug, int qb, int h, char* lds) {
  const int tid_ = ltid(); const int lane = tid_ & 63, ll = lane & 31, hh = lane >> 5;
  float* bt = (float*)(lds + (tid_ >> 6) * 2048);
  const bf16* Z = (const bf16*)(p.ws + W_Z);
  const bf16* NVT = (const bf16*)(p.ws + W_NVT);
  const int ub = ug * UT;
  const bool isctx = (g0 + ub) < UT;
  const int tq = ub + qb * 32 + ll;
  bf16x8 qf[4];
  {
    const bf16* qp = Z + (size_t)tq * ZS + C_BQ + h * 64 + hh * 8;
#pragma unroll
    for (int ks = 0; ks < 4; ++ks) qf[ks] = *(const bf16x8*)(qp + ks * 16);
  }
  f32x16 o[2];
  zero16(o[0]); zero16(o[1]);
  float m = -1e30f, lsum = 0.f;
  const bf16 *kb, *vb;
  size_t kstride, vstride;
  if (isctx) {
    int kt0 = ub + ((qb * 32) & ~255);
    kb = Z + (size_t)kt0 * ZS + C_BK + h * 64; kstride = ZS;
    vb = NVT + (size_t)(h * 64) * GT + kt0; vstride = GT;
  } else {
    int b = ((g0 >> 12) + ug) - 1;
    kb = (const bf16*)(p.ws + W_CK) + (size_t)((b * 2 + l) * 8 + h) * 256 * 64; kstride = 64;
    vb = (const bf16*)(p.ws + W_CVT) + (size_t)((b * 2 + l) * 8 + h) * 64 * 256; vstride = 256;
  }
  const int r = qb >> 1, c = (qb & 1) * 32 + ll;
  int rs = r - 4; rs = rs < 0 ? 0 : (rs > 56 ? 56 : rs);
  int cs = c - 8; cs = cs < 0 ? 0 : (cs > 48 ? 48 : cs);
  const float* rpb = p.na_rpb + (size_t)(l * 8 + h) * 15 * 31;
  if (!isctx) {
    for (int i = lane; i < 465; i += 64) bt[i] = rpb[i] * LOG2E;
  }
  const int nt = isctx ? 8 : 24;
  char* kl = lds + 8192 + (tid_ >> 6) * 8192;
  char* vl = kl + 4096;
  const int krow = lane >> 3, kch = lane & 7, vrow = lane >> 2, vch = lane & 3;
  uint4 kr0, kr1, kr2, kr3, vr0, vr1, vr2, vr3;
#define NA_LOAD(i_)                                                                                        \
  {                                                                                                        \
    const bf16 *kp_, *vp_;                                                                                 \
    size_t ks_, vs_;                                                                                       \
    if ((i_) < 8) { kp_ = kb + (size_t)((i_) * 32) * kstride; ks_ = kstride; vp_ = vb + (i_) * 32; vs_ = vstride; } \
    else {                                                                                                 \
      const int j_ = (i_) - 8, kt0_ = ub + (rs + (j_ >> 1)) * 64 + (j_ & 1) * 32;                          \
      kp_ = Z + (size_t)kt0_ * ZS + C_BK + h * 64; ks_ = ZS;                                               \
      vp_ = NVT + (size_t)(h * 64) * GT + kt0_; vs_ = GT;                                                  \
    }                                                                                                      \
    kp_ += (size_t)krow * ks_ + kch * 8; vp_ += (size_t)vrow * vs_ + vch * 8;                              \
    kr0 = *(const uint4*)(kp_); kr1 = *(const uint4*)(kp_ + 8 * ks_);                                      \
    kr2 = *(const uint4*)(kp_ + 16 * ks_); kr3 = *(const uint4*)(kp_ + 24 * ks_);                          \
    vr0 = *(const uint4*)(vp_); vr1 = *(const uint4*)(vp_ + 16 * vs_);                                     \
    vr2 = *(const uint4*)(vp_ + 32 * vs_); vr3 = *(const uint4*)(vp_ + 48 * vs_);                          \
  }
  const int kw0 = krow * 128, kx_ = krow >> 1, vw0 = vrow * 64 + ((vch ^ ((vrow >> 2) & 3)) << 4);
  const int kfo = ll * 128, kfx = (ll >> 1) & 7, vfx = (ll >> 2) & 3;
  NA_LOAD(0)
  for (int i = 0; i < nt; ++i) {
    *(uint4*)(kl + kw0 + ((kch ^ (kx_ & 7)) << 4)) = kr0;
    *(uint4*)(kl + kw0 + 1024 + ((kch ^ ((kx_ + 4) & 7)) << 4)) = kr1;
    *(uint4*)(kl + kw0 + 2048 + ((kch ^ (kx_ & 7)) << 4)) = kr2;
    *(uint4*)(kl + kw0 + 3072 + ((kch ^ ((kx_ + 4) & 7)) << 4)) = kr3;
    *(uint4*)(vl + vw0) = vr0; *(uint4*)(vl + vw0 + 1024) = vr1; *(uint4*)(vl + vw0 + 2048) = vr2; *(uint4*)(vl + vw0 + 3072) = vr3;
    { const int inx = i + 1 < nt ? i + 1 : i; NA_LOAD(inx) }
    f32x16 x;
    zero16(x);
#pragma unroll
    for (int ks = 0; ks < 4; ++ks) x = MFMA(*(const bf16x8*)(kl + kfo + (((2 * ks + hh) ^ kfx) << 4)), qf[ks], x);
    if (i >= 8) {
      const int j8 = i - 8, half = j8 & 1, kr = rs + (j8 >> 1);
      const float* rp = bt + (kr - r + 7) * 31 + 15 - c;
#pragma unroll
      for (int reg = 0; reg < 16; ++reg) {
        int j = half * 32 + rowoff(reg, hh);
        bool ok = (j >= cs) && (j < cs + 16);
        int jc = j < c - 15 ? c - 15 : (j > c + 15 ? c + 15 : j);
        x[reg] = x[reg] + rp[jc] + (ok ? 0.f : -1e30f);
      }
    }
    smax32<2>(x, m, lsum, o);
#pragma unroll
    for (int s2 = 0; s2 < 2; ++s2) {
      bf16x8 pf = packf8(x, s2);
#pragma unroll
      for (int e = 0; e < 2; ++e) {
        const char* vp = vl + (e * 32 + ll) * 64 + 8 * hh;
        o[e] = MFMA(comb(*(const uint2*)(vp + (((2 * s2) ^ vfx) << 4)), *(const uint2*)(vp + (((2 * s2 + 1) ^ vfx) << 4))), pf, o[e]);
      }
    }
  }
  float lt = lsum + __shfl_xor(lsum, 32);
  float inv = 1.f / lt;
  bf16* BR = (bf16*)(p.ws + W_BR);
#pragma unroll
  for (int e = 0; e < 2; ++e)
#pragma unroll
    for (int g4 = 0; g4 < 4; ++g4) {
      int ee = h * 64 + e * 32 + 8 * g4 + 4 * hh;
      uint2 gr = *(const uint2*)(Z + (size_t)tq * ZS + C_BG + ee);
      uint2 ov;
      ov.x = pack2(o[e][4 * g4] * inv * bf2f(gr.x & 0xffff), o[e][4 * g4 + 1] * inv * bf2f(gr.x >> 16));
      ov.y = pack2(o[e][4 * g4 + 2] * inv * bf2f(gr.y & 0xffff), o[e][4 * g4 + 3] * inv * bf2f(gr.y >> 16));
      *(uint2*)(BR + (size_t)tq * 2048 + 512 + ee) = ov;
    }
}

DEV void mla_job(const P& p, int g0, int ug, int qblk, int h, char* lds) {
  const int tid = ltid(), lane = tid & 63, w = tid >> 6, ll = lane & 31, hh = lane >> 5;
  const int ub = ug * UT;
  const bool isctx = (g0 + ub) < UT;
  const int tq = ub + qblk * 128 + w * 32 + ll;
  bf16x8 qf[12];
  {
    const bf16* qp = (const bf16*)(p.ws + W_QM) + (size_t)tq * 768 + h * 192 + hh * 8;
#pragma unroll
    for (int ks = 0; ks < 12; ++ks) qf[ks] = *(const bf16x8*)(qp + ks * 16);
  }
  const int key_lo = isctx ? (qblk >> 1) * 256 : 0, ntiles = isctx ? 8 : 136;
  const bf16* KNb = (const bf16*)(p.ws + W_KN) + (size_t)ug * KVR * 512 + h * 128;
  const bf16* KPb = (const bf16*)(p.ws + W_KPER) + (size_t)ug * KVR * 64;
  const bf16* VTb = (const bf16*)(p.ws + W_VT) + ((size_t)ug * 512 + h * 128) * KVR;
  const bf16* kptr[3];
  int kstr[3];
#pragma unroll
  for (int i = 0; i < 3; ++i) {
    int L = tid * 16 + i * 4096, row = L / 384, pos = (L - row * 384) >> 4, c = pos ^ ((row >> 1) & 7);
    if (c < 16) { kptr[i] = KNb + (size_t)(key_lo + row) * 512 + c * 8; kstr[i] = 32 * 512; }
    else { kptr[i] = KPb + (size_t)(key_lo + row) * 64 + (c - 16) * 8; kstr[i] = 32 * 64; }
  }
  const bf16* vptr[2];
#pragma unroll
  for (int i = 0; i < 2; ++i) {
    int e = (tid >> 2) + 64 * i, c = (tid & 3) ^ ((tid >> 4) & 3);
    vptr[i] = VTb + (size_t)e * KVR + key_lo + c * 8;
  }
  char* ldst = lds + tid * 16;
#define MLA_ISSUE(t)                                                                                                         \
  {                                                                                                                          \
    const int ks_ = (t) % 3, vs_ = (t) & 3;                                                                                  \
    _Pragma("unroll") for (int i = 0; i < 3; ++i) __builtin_amdgcn_global_load_lds(                                          \
        (const unsigned*)(kptr[i] + (size_t)(t) * kstr[i]), (__attribute__((address_space(3))) unsigned*)(ldst + ks_ * 12288 + i * 4096), 16, 0, 0); \
    _Pragma("unroll") for (int i = 0; i < 2; ++i) __builtin_amdgcn_global_load_lds(                                          \
        (const unsigned*)(vptr[i] + (size_t)(t) * 32), (__attribute__((address_space(3))) unsigned*)(ldst + 36864 + vs_ * 8192 + i * 4096), 16, 0, 0); \
  }
#define MLA_S(xout, t)                                                                                                       \
  {                                                                                                                          \
    const char* S_ = lds + ((t) % 3) * 12288;                                                                                \
    zero16(xout);                                                                                                            \
    _Pragma("unroll") for (int ks = 0; ks < 12; ++ks)                                                                        \
      xout = MFMA(*(const bf16x8*)(S_ + (ks >> 2) * 128 + klo[ks & 3]), qf[ks], xout);                                       \
  }
  const int kx = (ll >> 1) & 7, vx = (ll >> 2) & 3;
  int klo[4];
#pragma unroll
  for (int ks = 0; ks < 4; ++ks) klo[ks] = ll * 384 + (((2 * ks + hh) ^ kx) << 4);
  int vo[4];
#pragma unroll
  for (int c = 0; c < 4; ++c) vo[c] = 36864 + ll * 64 + ((c ^ vx) << 4) + 8 * hh;
  f32x16 o[4];
  zero16(o[0]); zero16(o[1]); zero16(o[2]); zero16(o[3]);
  float m = -1e30f, lsum = 0.f;
  const unsigned lds_base = lds_addr(lds);
  __syncthreads();
  MLA_ISSUE(0)
  MLA_ISSUE(1)
  MLA_ISSUE(2)
  asm volatile("s_waitcnt vmcnt(12)" ::: "memory");
  __builtin_amdgcn_s_barrier();
  f32x16 x;
  MLA_S(x, 0)
  for (int t = 0; t < ntiles; ++t) {
    if (t + 2 < ntiles) asm volatile("s_waitcnt vmcnt(7)" ::: "memory");
    else if (t + 1 < ntiles) asm volatile("s_waitcnt vmcnt(2)" ::: "memory");
    else asm volatile("s_waitcnt vmcnt(0)" ::: "memory");
    __builtin_amdgcn_s_barrier();
    if (t + 3 < ntiles) MLA_ISSUE(t + 3)
    f32x16 xn;
    if (t + 1 < ntiles) MLA_S(xn, t + 1)
    float mx = x[0];
#pragma unroll
    for (int i = 1; i < 16; ++i) mx = fmaxf(mx, x[i]);
    mx = xhalf_max(mx);
    if (__any(mx > m + 8.f)) {
      float mn = fmaxf(m, mx), al_ = ex2(m - mn);
      m = mn;
      lsum *= al_;
#pragma unroll
      for (int e = 0; e < 4; ++e)
#pragma unroll
        for (int i = 0; i < 16; ++i) o[e][i] *= al_;
    }
    float ps = 0.f;
#pragma unroll
    for (int i = 0; i < 16; ++i) { x[i] = ex2(x[i] - m); ps += x[i]; }
    lsum += ps;
    const unsigned vb_ = lds_base + (t & 3) * 8192;
#pragma unroll
    for (int s = 0; s < 2; ++s) {
      u32x2 vr[4][2];
#pragma unroll
      for (int e = 0; e < 4; ++e) { vr[e][0] = lds_rd64(vb_ + e * 2048 + vo[2 * s]); vr[e][1] = lds_rd64(vb_ + e * 2048 + vo[2 * s + 1]); }
      bf16x8 pf = packf8(x, s);
      asm volatile("s_waitcnt lgkmcnt(0)"
                   : "+v"(vr[0][0]), "+v"(vr[0][1]), "+v"(vr[1][0]), "+v"(vr[1][1]), "+v"(vr[2][0]), "+v"(vr[2][1]), "+v"(vr[3][0]), "+v"(vr[3][1]));
#pragma unroll
      for (int e = 0; e < 4; ++e) o[e] = MFMA(comb2(vr[e][0], vr[e][1]), pf, o[e]);
    }
    if (t + 1 < ntiles) {
#pragma unroll
      for (int i = 0; i < 16; ++i) x[i] = xn[i];
    }
  }
  float lt = lsum + __shfl_xor(lsum, 32);
  float inv = 1.f / lt;
  const bf16* Z = (const bf16*)(p.ws + W_Z);
  bf16* BR = (bf16*)(p.ws + W_BR);
#pragma unroll
  for (int e = 0; e < 4; ++e)
#pragma unroll
    for (int g4 = 0; g4 < 4; ++g4) {
      int ee = h * 128 + e * 32 + 8 * g4 + 4 * hh;
      uint2 gr = *(const uint2*)(Z + (size_t)tq * ZS + C_CG + ee);
      uint2 ov;
      ov.x = pack2(o[e][4 * g4] * inv * bf2f(gr.x & 0xffff), o[e][4 * g4 + 1] * inv * bf2f(gr.x >> 16));
      ov.y = pack2(o[e][4 * g4 + 2] * inv * bf2f(gr.y & 0xffff), o[e][4 * g4 + 3] * inv * bf2f(gr.y >> 16));
      *(uint2*)(BR + (size_t)tq * 2048 + 1024 + ee) = ov;
    }
}

#define HG_SCAN(LGPTR)                                                                     \
  float lgv[32];                                                                           \
  _Pragma("unroll") for (int r = 0; r < 32; ++r) lgv[r] = (LGPTR)[(size_t)r * 512];        \
  {                                                                                        \
    float run = 0.f;                                                                       \
    _Pragma("unroll") for (int r = 0; r < 32; ++r) run += lgv[r];                          \
    sTot[hf * 128 + d] = run;                                                              \
  }                                                                                        \
  __syncthreads();                                                                         \
  const float t0_ = sTot[d], t1_ = sTot[128 + d], tot = t0_ + t1_;                         \
  const float cm = dir == 0 ? t0_ : t1_;                                                   \
  float bb = dir == 0 ? (hf == 1 ? t0_ : 0.f) : (hf == 0 ? t1_ : 0.f);

#define HG_SCAN2(LGPTR)                                                                    \
  {                                                                                        \
    float run = 0.f;                                                                       \
    _Pragma("unroll 16") for (int r = 0; r < 32; ++r) run += (LGPTR)[(size_t)r * 512];     \
    sTot[hf * 128 + d] = run;                                                              \
  }                                                                                        \
  __syncthreads();                                                                         \
  const float t0_ = sTot[d], t1_ = sTot[128 + d];                                          \
  const float cm = dir == 0 ? t0_ : t1_;                                                   \
  float bb = dir == 0 ? (hf == 1 ? t0_ : 0.f) : (hf == 0 ? t1_ : 0.f);

DEV void hgrn_a(const P& p, int cid, int h, int dir, char* lds) {
  const int tid = ltid(), lane = tid & 63, w = tid >> 6, ll = lane & 31, hh = lane >> 5;
  const int d = tid & 127, hf = tid >> 7;
  bf16* kT = (bf16*)lds;
  bf16* vT = (bf16*)(lds + 128 * 144);
  float* sTot = (float*)(lds + 2 * 128 * 144);
  const int tl0 = cid * 64 + hf * 32;
  const int idx = (cid * 4 + h) * 2 + dir;
  const _Float16* LG = (const _Float16*)(p.ws + (dir ? W_LGB : W_LGF)) + (size_t)tl0 * 512 + h * 128 + d;
  __syncthreads();
  HG_SCAN(LG)
  {
    const bf16* vp = (const bf16*)(p.ws + W_Z) + (size_t)tl0 * ZS + C_AI + h * 128 + d;
    bf16 vv[32];
#pragma unroll
    for (int r = 0; r < 32; ++r) vv[r] = vp[(size_t)r * ZS];
    if (dir == 0) {
#pragma unroll
      for (int r = 0; r < 32; ++r) { const float lg = lgv[r]; bb += lg; kT[d * 72 + hf * 32 + r] = f2bf(-expm1f(lg) * __expf(tot - bb)); }
    } else {
#pragma unroll
      for (int r = 31; r >= 0; --r) { const float lg = lgv[r]; bb += lg; kT[d * 72 + hf * 32 + r] = f2bf(-expm1f(lg) * __expf(tot - bb)); }
    }
#pragma unroll
    for (int r = 0; r < 32; ++r) vT[d * 72 + hf * 32 + r] = vv[r];
  }
  if (hf == 0) {
    ((float*)(p.ws + W_BL))[(size_t)idx * 128 + d] = tot;
    ((float*)(p.ws + W_CM))[(size_t)idx * 128 + d] = cm;
  }
  __syncthreads();
  f32x16 acc[4];
  zero16(acc[0]); zero16(acc[1]); zero16(acc[2]); zero16(acc[3]);
#pragma unroll
  for (int ks = 0; ks < 4; ++ks) {
    bf16x8 a = *(const bf16x8*)(vT + (w * 32 + ll) * 72 + ks * 16 + hh * 8);
#pragma unroll
    for (int it = 0; it < 4; ++it) acc[it] = MFMA(a, *(const bf16x8*)(kT + (it * 32 + ll) * 72 + ks * 16 + hh * 8), acc[it]);
  }
  bf16* SU = (bf16*)(p.ws + W_SU) + (size_t)idx * 16384;
#pragma unroll
  for (int it = 0; it < 4; ++it)
#pragma unroll
    for (int reg = 0; reg < 16; ++reg) SU[(w * 32 + rowoff(reg, hh)) * 128 + it * 32 + ll] = f2bf(acc[it][reg]);
}

template <int UN>
DEV void hgrn_b(const P& p, int l, int cbase, int NC, int h, int dir, int es, const float* s0, float* sout, char* lds) {
  const int tid = ltid();
  const int e = es * 16 + (tid >> 4), i0 = (tid & 15) * 8;
  float S[8];
  float* tb_ = (float*)lds;
  const int ti_ = tid >> 1, th_ = (tid & 1) * 8;
  if (s0) {
    const float4 a0 = *(const float4*)(s0 + (size_t)ti_ * 128 + es * 16 + th_), a1 = *(const float4*)(s0 + (size_t)ti_ * 128 + es * 16 + th_ + 4);
    float* d = tb_ + ti_ * 17 + th_;
    d[0] = a0.x; d[1] = a0.y; d[2] = a0.z; d[3] = a0.w; d[4] = a1.x; d[5] = a1.y; d[6] = a1.z; d[7] = a1.w;
    __syncthreads();
#pragma unroll
    for (int j = 0; j < 8; ++j) S[j] = tb_[(i0 + j) * 17 + (tid >> 4)];
  } else {
#pragma unroll
    for (int j = 0; j < 8; ++j) S[j] = 0.f;
  }
  bf16* SU = (bf16*)(p.ws + W_SU);
  const float* BL = (const float*)(p.ws + W_BL);
  const float* CM = (const float*)(p.ws + W_CM);
  for (int n0 = 0; n0 < NC; n0 += UN) {
    uint4 U[UN];
    float4 bl[UN][2], cmv[UN][2];
#pragma unroll
    for (int q = 0; q < UN; ++q) {
      int n = n0 + q, cid = dir == 0 ? cbase + n : cbase + NC - 1 - n;
      size_t idx = (size_t)(cid * 4 + h) * 2 + dir;
      U[q] = *(const uint4*)(SU + idx * 16384 + e * 128 + i0);
      bl[q][0] = *(const float4*)(BL + idx * 128 + i0); bl[q][1] = *(const float4*)(BL + idx * 128 + i0 + 4);
      cmv[q][0] = *(const float4*)(CM + idx * 128 + i0); cmv[q][1] = *(const float4*)(CM + idx * 128 + i0 + 4);
    }
#pragma unroll
    for (int q = 0; q < UN; ++q) {
      int n = n0 + q, cid = dir == 0 ? cbase + n : cbase + NC - 1 - n;
      size_t idx = (size_t)(cid * 4 + h) * 2 + dir;
      const float* blf = (const float*)&bl[q][0];
      const float* cmf = (const float*)&cmv[q][0];
      const unsigned* uu = (const unsigned*)&U[q];
      uint4 o;
      unsigned* op = (unsigned*)&o;
#pragma unroll
      for (int j = 0; j < 8; j += 2) op[j >> 1] = pack2(S[j] * __expf(cmf[j]), S[j + 1] * __expf(cmf[j + 1]));
      *(uint4*)(SU + idx * 16384 + e * 128 + i0) = o;
#pragma unroll
      for (int j = 0; j < 8; ++j) {
        float uv = bf2f((bf16)((uu[j >> 1] >> ((j & 1) * 16)) & 0xffff));
        S[j] = __expf(blf[j]) * S[j] + uv;
      }
    }
  }
  if (sout) {
#pragma unroll
    for (int j = 0; j < 8; ++j) tb_[(i0 + j) * 17 + (tid >> 4)] = S[j];
    __syncthreads();
    const float* d = tb_ + ti_ * 17 + th_;
    *(float4*)(sout + (size_t)ti_ * 128 + es * 16 + th_) = make_float4(d[0], d[1], d[2], d[3]);
    *(float4*)(sout + (size_t)ti_ * 128 + es * 16 + th_ + 4) = make_float4(d[4], d[5], d[6], d[7]);
  }
}

DEV void hgrn_c(const P& p, int l, int cid, int h, char* lds) {
  const int tid = ltid(), lane = tid & 63, w = tid >> 6, ll = lane & 31, hh = lane >> 5;
  const int d = tid & 127, hf = tid >> 7;
  const int tt = w & 1, eh = w >> 1;
  bf16* qd = (bf16*)lds;
  bf16* kd = (bf16*)(lds + 64 * 272);
  bf16* vT = (bf16*)(lds + 2 * 64 * 272);
  float* sTot = (float*)(lds + 2 * 64 * 272 + 128 * 144);
  float* red = sTot + 256;
  const bf16* Z = (const bf16*)(p.ws + W_Z);
  const int tl0 = cid * 64 + hf * 32;
  f32x16 o[2];
  zero16(o[0]); zero16(o[1]);
#pragma unroll 1
  for (int dir = 0; dir < 2; ++dir) {
    const int idx = (cid * 4 + h) * 2 + dir;
    const _Float16* LG = (const _Float16*)(p.ws + (dir ? W_LGB : W_LGF)) + (size_t)tl0 * 512 + h * 128 + d;
    __syncthreads();
    bf16x8 sfr[2][8];
    {
      const bf16* Sg = (const bf16*)(p.ws + W_SU) + (size_t)idx * 16384;
#pragma unroll
      for (int e2 = 0; e2 < 2; ++e2)
#pragma unroll
        for (int ks = 0; ks < 8; ++ks) sfr[e2][ks] = *(const bf16x8*)(Sg + ((eh * 2 + e2) * 32 + ll) * 128 + ks * 16 + hh * 8);
    }
    const float tot_ = ((const float*)(p.ws + W_BL))[(size_t)idx * 128 + d], cm = ((const float*)(p.ws + W_CM))[(size_t)idx * 128 + d];
    const float t0_ = dir == 0 ? cm : tot_ - cm, t1_ = dir == 0 ? tot_ - cm : cm;
    float bb = dir == 0 ? (hf == 1 ? t0_ : 0.f) : (hf == 0 ? t1_ : 0.f);
    {
      const bf16* qp = Z + (size_t)tl0 * ZS + C_AQ + h * 128 + d;
      const bf16* vp = Z + (size_t)tl0 * ZS + C_AI + h * 128 + d;
#pragma unroll
      for (int rr = 0; rr < 32; ++rr) {
        const int r = dir == 0 ? rr : 31 - rr;
        const float lg = LG[(size_t)r * 512];
        bb += lg;
        const float qv = bf2f(qp[(size_t)r * ZS]);
        qd[(hf * 32 + r) * 136 + d] = f2bf(qv * __expf(bb - cm));
        kd[(hf * 32 + r) * 136 + d] = f2bf(-expm1f(lg) * __expf(cm - bb));
        if (dir == 0) vT[d * 72 + hf * 32 + r] = vp[(size_t)r * ZS];
      }
    }
    __syncthreads();
    bf16x8 qf[8];
#pragma unroll
    for (int ks = 0; ks < 8; ++ks) qf[ks] = *(const bf16x8*)(qd + (tt * 32 + ll) * 136 + ks * 16 + hh * 8);
#pragma unroll
    for (int st = 0; st < 2; ++st) {
      const bool use = dir == 0 ? (st <= tt) : (st >= tt);
      if (!use) continue;
      f32x16 x;
      zero16(x);
#pragma unroll
      for (int ks = 0; ks < 8; ++ks) x = MFMA(*(const bf16x8*)(kd + (st * 32 + ll) * 136 + ks * 16 + hh * 8), qf[ks], x);
      if (st == tt) {
#pragma unroll
        for (int reg = 0; reg < 16; ++reg) {
          int sl = rowoff(reg, hh);
          bool keep = dir == 0 ? (sl <= ll) : (sl >= ll);
          x[reg] = keep ? x[reg] : 0.f;
        }
      }
#pragma unroll
      for (int s2 = 0; s2 < 2; ++s2) {
        bf16x8 pf = packf8n(x, s2);
#pragma unroll
        for (int e2 = 0; e2 < 2; ++e2) {
          const bf16* vp = vT + ((eh * 2 + e2) * 32 + ll) * 72 + st * 32 + 16 * s2 + 4 * hh;
          o[e2] = MFMA(comb(*(const uint2*)vp, *(const uint2*)(vp + 8)), pf, o[e2]);
        }
      }
    }
#pragma unroll
    for (int e2 = 0; e2 < 2; ++e2)
#pragma unroll
      for (int ks = 0; ks < 8; ++ks) o[e2] = MFMA(sfr[e2][ks], qf[ks], o[e2]);
  }
  float ss = 0.f;
#pragma unroll
  for (int e2 = 0; e2 < 2; ++e2)
#pragma unroll
    for (int i = 0; i < 16; ++i) ss += o[e2][i] * o[e2][i];
  ss += __shfl_xor(ss, 32);
  if (hh == 0) red[eh * 64 + tt * 32 + ll] = ss;
  __syncthreads();
  const float rstd = rsqrtf((red[tt * 32 + ll] + red[64 + tt * 32 + ll]) * (1.f / 128.f) + EPS);
  const int tl = cid * 64 + tt * 32 + ll;
  bf16* BR = (bf16*)(p.ws + W_BR);
#pragma unroll
  for (int e2 = 0; e2 < 2; ++e2)
#pragma unroll
    for (int g4 = 0; g4 < 4; ++g4) {
      int e = (eh * 2 + e2) * 32 + 8 * g4 + 4 * hh;
      float4 ng = *(const float4*)(p.hg_norm_g + l * 128 + e);
      uint2 gr = *(const uint2*)(Z + (size_t)tl * ZS + C_AG + h * 128 + e);
      uint2 ov;
      ov.x = pack2(o[e2][4 * g4] * rstd * ng.x * bf2f(gr.x & 0xffff), o[e2][4 * g4 + 1] * rstd * ng.y * bf2f(gr.x >> 16));
      ov.y = pack2(o[e2][4 * g4 + 2] * rstd * ng.z * bf2f(gr.y & 0xffff), o[e2][4 * g4 + 3] * rstd * ng.w * bf2f(gr.y >> 16));
      *(uint2*)(BR + (size_t)tl * 2048 + h * 128 + e) = ov;
    }
}

#define XB_TMO      128
#define XB_XCNT(j)  (256  + 64 * (j))
#define XB_XSUB(j)  (1280 + 64 * (j))
#define XB_XGEN(j)  (2304 + 64 * (j))
#define XB_TOP      3328
#define XB_TOPGEN   3392
#define XCD_BAR_WORDS 3456
#define XB_SPIN_CAP (1u << 18)
#define LAS __attribute__((address_space(3)))

__device__ __forceinline__ unsigned xb_ld(unsigned* p)              { return __hip_atomic_load(p, __ATOMIC_RELAXED, __HIP_MEMORY_SCOPE_AGENT); }
__device__ __forceinline__ unsigned xb_add(unsigned* p, unsigned v) { return __hip_atomic_fetch_add(p, v, __ATOMIC_RELAXED, __HIP_MEMORY_SCOPE_AGENT); }
__device__ __forceinline__ unsigned xb_xcc_id() { return (unsigned)__builtin_amdgcn_s_getreg((3 << 11) | 20) & 0xFu; }
#define XB_SPIN(cond, bar) do { unsigned _sp = 0; while (cond) { __builtin_amdgcn_s_sleep(1); \
    if ((++_sp & 255u) == 0u) { if (xb_ld(&(bar)[XB_TMO])) break; if (_sp > XB_SPIN_CAP) { atomicAdd(&(bar)[XB_TMO], 1u); break; } } } } while (0)

struct XcdBarrier {
    unsigned* bar; unsigned x;
    volatile LAS unsigned* st;
};

__device__ __forceinline__ XcdBarrier xcd_barrier_post(unsigned* bar, volatile LAS unsigned* st) {
    XcdBarrier b; b.bar = bar; b.x = xb_xcc_id(); b.st = st;
    if (threadIdx.x == 0) (void)xb_add(&bar[XB_XCNT(b.x)], 1u);
    return b;
}
__device__ __forceinline__ void xcd_barrier_complete(unsigned* bar, unsigned x, unsigned& nloc, unsigned& nx) {
    const unsigned G = gridDim.x * gridDim.y * gridDim.z;
    unsigned sum, cnt, mine, sp = 0u;
    for (;;) {
        sum = 0u; cnt = 0u; mine = 0u;
#pragma unroll
        for (unsigned j = 0; j < 16; ++j) { const unsigned c = xb_ld(&bar[XB_XCNT(j)]); sum += c; cnt += (c > 0u) ? 1u : 0u; mine = (j == x) ? c : mine; }
        if (sum == G) break;
        __builtin_amdgcn_s_sleep(1);
        if ((++sp & 255u) == 0u) { if (xb_ld(&bar[XB_TMO])) break; if (sp > XB_SPIN_CAP) { atomicAdd(&bar[XB_TMO], 1u); break; } }
    }
    nloc = mine > 0u ? mine : 1u; nx = cnt > 0u ? cnt : 1u;
}

__device__ __forceinline__ void xcd_barrier(const XcdBarrier& b) {
    asm volatile("s_waitcnt vmcnt(0)" ::: "memory");
    __syncthreads();
    if (threadIdx.x == 0) {
        unsigned* bar = b.bar;
        __builtin_amdgcn_s_waitcnt(0);
        unsigned nloc = b.st[0], nx = b.st[1];
        if (nloc == 0u) { xcd_barrier_complete(bar, b.x, nloc, nx); b.st[0] = nloc; b.st[1] = nx; }
        const unsigned old = xb_add(&bar[XB_XSUB(b.x)], 1u);
        const unsigned gen = old / nloc;
        if (old + 1u == (gen + 1u) * nloc) {
            __builtin_amdgcn_fence(__ATOMIC_RELEASE, "agent");
            asm volatile("s_waitcnt vmcnt(0)" ::: "memory");
            const unsigned og = xb_add(&bar[XB_TOP], 1u);
            const unsigned tg = og / nx;
            if (og + 1u == (tg + 1u) * nx) xb_add(&bar[XB_TOPGEN], 1u);
            else XB_SPIN(xb_ld(&bar[XB_TOPGEN]) == tg, bar);
            __builtin_amdgcn_fence(__ATOMIC_ACQUIRE, "agent");
            xb_add(&bar[XB_XGEN(b.x)], 1u);
            asm volatile("s_waitcnt vmcnt(0)" ::: "memory");
        } else {
            XB_SPIN(xb_ld(&bar[XB_XGEN(b.x)]) == gen, bar);
            __builtin_amdgcn_fence(__ATOMIC_ACQUIRE, "agent");
            asm volatile("s_waitcnt vmcnt(0)" ::: "memory");
        }
    }
    __syncthreads();
}


DEV int next_job(unsigned* ctr, int* sjob) {
  __syncthreads();
  if (threadIdx.x == 0) *sjob = (int)atomicAdd(ctr, 1u);
  __syncthreads();
  return *sjob;
}

__global__ void __launch_bounds__(256, 2) mega(P p) {
  extern __shared__ __attribute__((aligned(16))) char lds[];
  cg::grid_group grid = cg::this_grid();
  const int nb = gridDim.x, bid = blockIdx.x;
  __shared__ uint4 xb_words;
  int* sjob = (int*)&xb_words + 2;
  unsigned* qctr = (unsigned*)(p.ws + W_CTR) + 3584;
  if (threadIdx.x == 0) xb_words = make_uint4(0u, 0u, 0u, 0u);
  __syncthreads();
  XcdBarrier xb = xcd_barrier_post((unsigned*)(p.ws + W_CTR), (volatile LAS unsigned*)&xb_words);

  {
    const int J0 = 2 * 16 * 183, J1 = J0 + 8 * 8 * 16, J2 = J1 + 2 * 16 * 16, J3 = J2 + 2 * 4 * 12, J4 = J3 + 2 * 2 * 16,
              J5 = J4 + 96, J6 = J5 + 128;
    for (int job = bid; job < J6; job += nb) {
      if (job < J0) {
        int l = job / (16 * 183), r = job % (16 * 183);
        tr_tile(p.w_in + (size_t)l * 1024 * ZW, (bf16*)(p.ws + W_WIN) + (size_t)l * ZW * 1024, 1024, ZW, r & 15, r >> 4, lds);
      } else if (job < J1) {
        int j = job - J0, mtx = j >> 7, r = j & 127;
        tr_tile(p.w_branch + (size_t)mtx * 512 * 1024, (bf16*)(p.ws + W_WBR) + (size_t)(mtx >> 2) * 1024 * 2048 + (mtx & 3) * 512, 512, 1024, r & 7, r >> 3, lds, 2048);
      } else if (job < J2) {
        int j = job - J1, l = j >> 8, r = j & 255;
        tr_tile(p.w_out + (size_t)l * 1024 * 1024, (bf16*)(p.ws + W_WOUT) + (size_t)l * 1024 * 1024, 1024, 1024, r & 15, r >> 4, lds);
      } else if (job < J3) {
        int j = job - J2, l = j / 48, r = j % 48;
        tr_tile(p.w_qb + (size_t)l * 256 * 768, (bf16*)(p.ws + W_WQB) + (size_t)l * 768 * 256, 256, 768, r & 3, r >> 2, lds);
      } else if (job < J4) {
        int j = job - J3, l = j >> 5, r = j & 31;
        tr_tile(p.w_kvb + (size_t)l * 128 * 1024, (bf16*)(p.ws + W_WKVB) + (size_t)l * 1024 * 128, 128, 1024, r & 1, r >> 1, lds);
      } else if (job < J5) {
        int j = job - J4;
        mod_job(p, j / 48, j % 48, lds);
      } else {
        cache_job(p, job - J5, lds);
      }
    }
  }
  grid.sync();

  for (int grp = 0; grp < 9 / GU; ++grp) {
    const int u0 = grp * GU, nu = GU, g0 = u0 * UT;
    const int nlat = (grp == 0) ? nu - 1 : nu;
    const int ulat0 = (grp == 0) ? 1 : 0;
    const int MT = nu * 32;
    for (int job = bid; job < nu * 256; job += nb) h_job(p, 0, g0, job);
    xcd_barrier(xb);
    for (int l = 0; l < 2; ++l) {
      {
        const int mpx = MT >> 3, xq = bid & 7, local = bid >> 3, npl = (nb >> 3) / mpx;
        if (local < npl * mpx)
          for (int nt = local / mpx; nt < 60; nt += npl) gemm1_job(p, l, g0, xq * mpx + local % mpx, nt * 128, C_MG, lds);
      }
      xcd_barrier(xb);
      {
        const int J1 = nu * 512, J2 = J1 + nu * 128, J3 = J2 + nlat * 8, J4 = J3 + nu * 128;
        unsigned* ctr = qctr++;
        for (int job = next_job(ctr, sjob); job < J4; job = next_job(ctr, sjob)) {
          if (job < J1) {
            hgrn_a(p, job >> 3, (job >> 1) & 3, job & 1, lds);
          } else if (job < J2) {
            mlaprep_job(p, l, g0, job - J1);
          } else if (job < J3) {
            int j = job - J2;
            mlatail_job(p, l, g0, ulat0 + (j >> 3), j & 7);
          } else {
            conv_job(p, l, g0, job - J3);
          }
        }
      }
      xcd_barrier(xb);
      {
        const int nctx = nu - nlat;
        const int J0 = nlat * 64, J1 = J0 + nctx * 1024, J2 = J1 + MT * 6, J3 = J2 + nu * 34 * 8;
        unsigned* ctr = qctr++;
        for (int job = next_job(ctr, sjob); job < J3; job = next_job(ctr, sjob)) {
          if (job < J0) {
            int ug = ulat0 + (job >> 6), r = job & 63, es = r & 7, ch = r >> 3, h = ch >> 1, dir = ch & 1;
            int b = ((g0 >> 12) + ug) - 1;
            hgrn_b<8>(p, l, ug * 64, 64, h, dir, es, p.state_hgrn + ((size_t)((b * 2 + l) * 2 + dir) * 4 + h) * 16384, nullptr, lds);
          } else if (job < J1) {
            int j = job - J0, es = j & 7, ch = j >> 3, dir = ch & 1, h = (ch >> 1) & 3, seq = ch >> 3;
            hgrn_b<4>(p, l, seq * 4, 4, h, dir, es, nullptr, p.out + O_ST + ((size_t)((seq * 2 + l) * 2 + dir) * 4 + h) * 16384, lds);
          } else if (job < J2) {
            int j = job - J1;
            gemmq_job(p, l, g0, j / 6, j % 6, lds);
          } else {
            int j = job - J2, ug = j / 272, r = j % 272, mt = r >> 3, nt = r & 7;
            bool isctx = (g0 + ug * UT) < UT;
            if (isctx && mt >= 32) continue;
            gemmkv_job(p, l, ug, mt, nt, lds);
          }
        }
      }
      xcd_barrier(xb);
      {
        {
          const int xq = bid & 7, local = bid >> 3, npairs = nu * 4;
          if (npairs == 12 && (nb >> 3) >= 48) {
            if (local < 32) mla_job(p, g0, xq >> 2, local, xq & 3, lds);
            else if (local < 48) { const int pp = 8 + (xq >> 1); mla_job(p, g0, pp >> 2, (xq & 1) * 16 + (local - 32), pp & 3, lds); }
          } else {
            const int npx = (npairs - xq + 7) >> 3;
            for (int jj = local; jj < 32 * npx; jj += (nb >> 3)) {
              const int pp = xq + 8 * (jj >> 5);
              mla_job(p, g0, pp >> 2, jj & 31, pp & 3, lds);
            }
          }
        }
        const int J1 = nu * 256, J2 = J1 + nu * 256;
        unsigned* ctr = qctr++;
        for (int job = next_job(ctr, sjob); job < J2; job = next_job(ctr, sjob)) {
          if (job < J1) {
            int ug = job >> 8, r = job & 255;
            na_wave(p, l, g0, ug, r >> 1, (r & 1) * 4 + (ltid() >> 6), lds);
          } else {
            int j = job - J1;
            hgrn_c(p, l, j >> 2, j & 3, lds);
          }
        }
      }
      xcd_barrier(xb);
      {
        const int xq = bid & 7, local = bid >> 3, hm = MT >> 1;
        for (int j = local; j < 2 * hm; j += (nb >> 3)) gemm3_job(p, l, (xq >> 2) * hm + (j >> 1), 2 * (xq & 3) + (j & 1), lds);
      }
      xcd_barrier(xb);
      {
        const int xq = bid & 7, local = bid >> 3, hm = MT >> 1;
        for (int j = local; j < 2 * hm; j += (nb >> 3)) gemm4_job(p, l, g0, (xq >> 2) * hm + (j >> 1), 2 * (xq & 3) + (j & 1), lds);
      }
      xcd_barrier(xb);
      for (int job = bid; job < nu * 256; job += nb) ln_job(p, l, g0, job);
      xcd_barrier(xb);
    }
  }
}

extern "C" void kernel_launch(void* const* d_in, const int* in_sizes, int n_in, void* d_out, int out_size, void* d_ws,
                              size_t ws_size, hipStream_t stream) {
  static int grid_blocks = 0;
  if (!grid_blocks) {
    int dev = 0, cus = 0, per_cu = 0;
    hipGetDevice(&dev);
    hipDeviceGetAttribute(&cus, hipDeviceAttributeMultiprocessorCount, dev);
    hipFuncSetAttribute((const void*)mega, hipFuncAttributeMaxDynamicSharedMemorySize, LDS_BYTES);
    hipOccupancyMaxActiveBlocksPerMultiprocessor(&per_cu, mega, 256, LDS_BYTES);
    if (per_cu > 2) per_cu = 2;
    if (per_cu < 1) per_cu = 1;
    grid_blocks = cus * per_cu;
  }
  if (ws_size < W_END) fprintf(stderr, "workspace too small: %zu < %zu\n", ws_size, (size_t)W_END);
  P p{};
  const float** pp = (const float**)&p;
  for (int i = 0; i < 25; ++i) pp[i] = (const float*)d_in[i];
  p.out = (float*)d_out;
  p.ws = (char*)d_ws;
  void* args[] = {&p};
  (void)hipMemsetAsync((char*)d_ws + W_CTR, 0, 16384, stream);
  hipError_t e = hipLaunchCooperativeKernel((const void*)mega, dim3(grid_blocks), dim3(256), args, LDS_BYTES, stream);
  if (e != hipSuccess) fprintf(stderr, "cooperative launch failed: %s (grid %d)\n", hipGetErrorString(e), grid_blocks);
}
```

```cpp
#include <hip/hip_runtime.h>
#include <hip/hip_cooperative_groups.h>
#include <cstdio>
namespace cg = cooperative_groups;

typedef unsigned short bf16;
typedef __attribute__((ext_vector_type(8))) short bf16x8;
typedef __attribute__((ext_vector_type(16))) float f32x16;
#define DEV __device__ __forceinline__
#define MFMA(a, b, c) __builtin_amdgcn_mfma_f32_32x32x16_bf16((a), (b), (c), 0, 0, 0)

constexpr int ZW = 11712, ZS = 7616, GU = 3, GT = GU * 4096, UT = 4096, KVR = 4352;
constexpr float LOG2E = 1.4426950408889634f;
constexpr float QS_NA = 0.125f * LOG2E;
constexpr float QS_MLA = 0.07216878364870322f * LOG2E;
constexpr float EPS = 1e-6f;
constexpr float ALPHA = 1.4142135623730951f;
constexpr int C_AQ = 0, C_AFF = 512, C_AFB = 1024, C_AI = 1536, C_AG = 2048, C_BQ = 2560, C_BK = 3072,
              C_BV = 3584, C_BG = 4096, C_QD = 4608, C_KVD = 4864, C_KPE = 4992, C_CG = 5056, C_DB = 5568,
              C_DC = 6080, C_DX = 6592, C_DG = 7104, C_MG = 7616;
constexpr size_t O_ST = 37748736, O_NK = 41943040, O_NV = 46137344, O_CKV = 50331648, O_KPE = 51380224;

constexpr size_t al(size_t x) { return (x + 255) & ~(size_t)255; }
constexpr size_t W_CTR = 0;
constexpr size_t W_WIN = 16384;
constexpr size_t W_WBR = W_WIN + al((size_t)2 * ZW * 1024 * 2);
constexpr size_t W_WOUT = W_WBR + al((size_t)2 * 4 * 1024 * 512 * 2);
constexpr size_t W_WQB = W_WOUT + al((size_t)2 * 1024 * 1024 * 2);
constexpr size_t W_WKVB = W_WQB + al((size_t)2 * 768 * 256 * 2);
constexpr size_t W_MOD = W_WKVB + al((size_t)2 * 1024 * 128 * 2);
constexpr size_t W_CK = W_MOD + al((size_t)2 * 9 * 3072 * 4);
constexpr size_t W_CVT = W_CK + al((size_t)8 * 2 * 8 * 256 * 64 * 2);
constexpr size_t W_H = W_CVT + al((size_t)8 * 2 * 8 * 256 * 64 * 2);
constexpr size_t W_Z = W_H + al((size_t)GT * 1024 * 2);
constexpr size_t W_LGF = W_Z + al((size_t)GT * ZS * 2);
constexpr size_t W_LGB = W_LGF + (size_t)GT * 512 * 4;
constexpr size_t W_SU = W_LGB + (size_t)GT * 512 * 4;
constexpr size_t W_G = W_LGF;
constexpr size_t W_KVPE = W_SU + al((size_t)(GT / 64) * 8 * 16384 * 2);
constexpr size_t W_NVT = W_KVPE + al((size_t)GT * 192 * 4);
constexpr size_t W_QN = W_NVT + al((size_t)512 * GT * 2);
constexpr size_t W_QM = W_QN + (size_t)GT * 256 * 2;
constexpr size_t W_MB = W_QN;
constexpr size_t W_CKVB = W_QM + al((size_t)GT * 768 * 2);
constexpr size_t W_KPER = W_CKVB + al((size_t)GU * KVR * 128 * 2);
constexpr size_t W_KN = W_KPER + al((size_t)GU * KVR * 64 * 2);
constexpr size_t W_VT = W_KN + al((size_t)GU * KVR * 512 * 2);
constexpr size_t W_BL = W_VT + al((size_t)GU * 512 * KVR * 2);
constexpr size_t W_CM = W_BL + al((size_t)(GT / 64) * 8 * 128 * 4);
constexpr size_t W_BR = W_CM + al((size_t)(GT / 64) * 8 * 128 * 4);
constexpr size_t W_END = W_BR + al((size_t)GT * 2048 * 2);
static_assert(W_END <= (size_t)512 * 1024 * 1024, "workspace layout exceeds 512 MiB");

constexpr int LDS_BYTES = 73728;
#ifndef DUP
#define DUP 0
#endif

struct P {
  const float *x_prompt, *x_sample, *state_hgrn, *cache_na_k, *cache_na_v, *cache_ckv, *cache_kpe, *c, *c_ctx,
      *w_ada, *b_ada, *w_in, *b_in, *lb_logits, *hg_norm_g, *na_rpb, *qnorm_g, *w_qb, *kvnorm_g, *w_kvb,
      *conv_w, *w_branch, *w_out, *ln_g, *ln_b;
  float* out;
  char* ws;
};

DEV bf16 f2bf(float f) { unsigned u = __float_as_uint(f); u += 0x7fffu + ((u >> 16) & 1u); return (bf16)(u >> 16); }
DEV float bf2f(bf16 b) { return __uint_as_float(((unsigned)b) << 16); }
DEV unsigned pack2(float a, float b) { unsigned r; asm("v_cvt_pk_bf16_f32 %0, %1, %2" : "=v"(r) : "v"(a), "v"(b)); return r; }
DEV float silu(float x) { return x * __builtin_amdgcn_rcpf(1.f + __expf(-x)); }
DEV float sigm(float x) { return __builtin_amdgcn_rcpf(1.f + __expf(-x)); }
DEV float ex2(float x) { return __builtin_amdgcn_exp2f(x); }
DEV int ltid() { int t = threadIdx.x; asm volatile("" : "+v"(t)); return t; }
typedef unsigned u32x2 __attribute__((ext_vector_type(2)));
DEV u32x2 lds_rd64(unsigned addr) { u32x2 v; asm volatile("ds_read_b64 %0, %1" : "=v"(v) : "v"(addr)); return v; }
DEV unsigned lds_addr(const void* p) { return (unsigned)(size_t)(__attribute__((address_space(3))) const char*)p; }
DEV bf16x8 comb2(u32x2 a, u32x2 b) { uint4 u = make_uint4(a.x, a.y, b.x, b.y); return *(bf16x8*)&u; }
DEV float xhalf_max(float x) {
  auto r = __builtin_amdgcn_permlane32_swap(__float_as_uint(x), __float_as_uint(x), false, false);
  return fmaxf(__uint_as_float(r[0]), __uint_as_float(r[1]));
}
DEV int rowoff(int reg, int hh) { return (reg & 3) + 8 * (reg >> 2) + 4 * hh; }
DEV bf16x8 packf8(const f32x16& x, int s) {
  uint4 u;
  u.x = pack2(x[8 * s + 0], x[8 * s + 1]); u.y = pack2(x[8 * s + 2], x[8 * s + 3]);
  u.z = pack2(x[8 * s + 4], x[8 * s + 5]); u.w = pack2(x[8 * s + 6], x[8 * s + 7]);
  return *(bf16x8*)&u;
}
typedef __bf16 nbf16x2 __attribute__((ext_vector_type(2)));
typedef float nf32x2 __attribute__((ext_vector_type(2)));
DEV unsigned pack2n(float a, float b) { nf32x2 v = {a, b}; nbf16x2 h = __builtin_convertvector(v, nbf16x2); return *(unsigned*)&h; }
DEV bf16x8 packf8n(const f32x16& x, int s) {
  uint4 u;
  u.x = pack2n(x[8 * s + 0], x[8 * s + 1]); u.y = pack2n(x[8 * s + 2], x[8 * s + 3]);
  u.z = pack2n(x[8 * s + 4], x[8 * s + 5]); u.w = pack2n(x[8 * s + 6], x[8 * s + 7]);
  return *(bf16x8*)&u;
}
DEV bf16x8 comb(uint2 a, uint2 b) { uint4 u = make_uint4(a.x, a.y, b.x, b.y); return *(bf16x8*)&u; }
DEV const float* xin_row(const P& p, int g) {
  return g < UT ? p.x_prompt + (size_t)g * 1024 : p.x_sample + (size_t)(g - UT) * 1024;
}
DEV void zero16(f32x16& a) {
#pragma unroll
  for (int i = 0; i < 16; ++i) a[i] = 0.f;
}

struct NoHook { DEV void operator()(int) const {} };
template <int BN, typename HOOK = NoHook>
DEV void gemm_core(f32x16 (&acc)[2][BN / 64], const bf16* __restrict__ A, int lda, const bf16* __restrict__ Bt,
                   int ldb, int nvalid, int K, char* lds, HOOK hook = NoHook()) {
  constexpr int NB = BN / 32;
  constexpr int WN = BN / 2;
  constexpr int STAGE = (128 + BN) * 128;
  const int tid = ltid(), lane = tid & 63, w = tid >> 6, wm = w >> 1, wn = w & 1, ll = lane & 31, hh = lane >> 5;
  const int lrow = tid >> 3, lch = (tid & 7) ^ ((tid >> 4) & 7);
  const bf16* abase = A + (size_t)lrow * lda + lch * 8;
  const bf16* bptr[NB];
#pragma unroll
  for (int i = 0; i < NB; ++i) { int r = lrow + 32 * i; r = r < nvalid ? r : nvalid - 1; bptr[i] = Bt + (size_t)r * ldb + lch * 8; }
  char* ldst = lds + tid * 16;
  const int key = (ll >> 1) & 7;
  int koff[4];
#pragma unroll
  for (int ks = 0; ks < 4; ++ks) koff[ks] = ((2 * ks + hh) ^ key) * 16;
  __syncthreads();
#pragma unroll
  for (int i = 0; i < 4; ++i)
    __builtin_amdgcn_global_load_lds((const unsigned*)(abase + (size_t)(32 * i) * lda), (__attribute__((address_space(3))) unsigned*)(ldst + i * 4096), 16, 0, 0);
#pragma unroll
  for (int i = 0; i < NB; ++i)
    __builtin_amdgcn_global_load_lds((const unsigned*)(bptr[i]), (__attribute__((address_space(3))) unsigned*)(ldst + 16384 + i * 4096), 16, 0, 0);
  asm volatile("s_waitcnt vmcnt(0)" ::: "memory");
  __syncthreads();
  const int nk = K >> 6;
  for (int kt = 0; kt < nk; ++kt) {
    if (kt + 1 < nk) {
      char* d = ldst + ((kt + 1) & 1) * STAGE;
#pragma unroll
      for (int i = 0; i < 4; ++i)
        __builtin_amdgcn_global_load_lds((const unsigned*)(abase + (size_t)(32 * i) * lda + (kt + 1) * 64), (__attribute__((address_space(3))) unsigned*)(d + i * 4096), 16, 0, 0);
#pragma unroll
      for (int i = 0; i < NB; ++i)
        __builtin_amdgcn_global_load_lds((const unsigned*)(bptr[i] + (kt + 1) * 64), (__attribute__((address_space(3))) unsigned*)(d + 16384 + i * 4096), 16, 0, 0);
    }
    const char* s = lds + (kt & 1) * STAGE;
    const char* sa = s + (wm * 64 + ll) * 128;
    const char* sb = s + 16384 + (wn * WN + ll) * 128;
#pragma unroll
    for (int ks = 0; ks < 4; ++ks) {
      bf16x8 a0 = *(const bf16x8*)(sa + koff[ks]), a1 = *(const bf16x8*)(sa + 32 * 128 + koff[ks]);
#pragma unroll
      for (int ni = 0; ni < BN / 64; ++ni) {
        bf16x8 b = *(const bf16x8*)(sb + ni * 32 * 128 + koff[ks]);
        acc[0][ni] = MFMA(a0, b, acc[0][ni]);
        acc[1][ni] = MFMA(a1, b, acc[1][ni]);
      }
    }
    __builtin_amdgcn_sched_group_barrier(0x100, 8, 0);
    __builtin_amdgcn_sched_group_barrier(0x008, 4, 0);
    __builtin_amdgcn_sched_group_barrier(0x100, 4, 0);
    __builtin_amdgcn_sched_group_barrier(0x008, 4, 0);
    __builtin_amdgcn_sched_group_barrier(0x100, 4, 0);
    __builtin_amdgcn_sched_group_barrier(0x008, 8, 0);
    hook(kt);
    asm volatile("s_waitcnt vmcnt(0)" ::: "memory");
    __syncthreads();
  }
}

DEV void tr_tile(const float* __restrict__ src, bf16* __restrict__ dst, int K, int N, int kt, int nt, char* lds, int dstK = 0) {
  if (dstK == 0) dstK = K;
  float* t = (float*)lds;
  const int tid = ltid();
  __syncthreads();
#pragma unroll
  for (int i = 0; i < 4; ++i) {
    int k = (tid >> 4) + 16 * i, n4 = (tid & 15) * 4;
    float4 v = *(const float4*)(src + (size_t)(kt * 64 + k) * N + nt * 64 + n4);
    t[k * 65 + n4] = v.x; t[k * 65 + n4 + 1] = v.y; t[k * 65 + n4 + 2] = v.z; t[k * 65 + n4 + 3] = v.w;
  }
  __syncthreads();
  const int n = tid >> 2, k0 = (tid & 3) * 16;
  uint4 o0, o1;
  o0.x = pack2(t[(k0 + 0) * 65 + n], t[(k0 + 1) * 65 + n]); o0.y = pack2(t[(k0 + 2) * 65 + n], t[(k0 + 3) * 65 + n]);
  o0.z = pack2(t[(k0 + 4) * 65 + n], t[(k0 + 5) * 65 + n]); o0.w = pack2(t[(k0 + 6) * 65 + n], t[(k0 + 7) * 65 + n]);
  o1.x = pack2(t[(k0 + 8) * 65 + n], t[(k0 + 9) * 65 + n]); o1.y = pack2(t[(k0 + 10) * 65 + n], t[(k0 + 11) * 65 + n]);
  o1.z = pack2(t[(k0 + 12) * 65 + n], t[(k0 + 13) * 65 + n]); o1.w = pack2(t[(k0 + 14) * 65 + n], t[(k0 + 15) * 65 + n]);
  bf16* d = dst + (size_t)(nt * 64 + n) * dstK + kt * 64 + k0;
  *(uint4*)d = o0; *(uint4*)(d + 8) = o1;
}

DEV void mod_job(const P& p, int l, int cb, char* lds) {
  float* sc = (float*)lds;
  float* red = sc + 9 * 1024;
  const int tid = ltid();
  __syncthreads();
  for (int i = tid; i < 9 * 1024; i += 256) {
    int c = i >> 10, k = i & 1023;
    float v = c == 0 ? p.c_ctx[k] : p.c[(c - 1) * 1024 + k];
    sc[i] = silu(v);
  }
  __syncthreads();
  const int col = cb * 64 + (tid & 63), kq = tid >> 6;
  float a[9];
#pragma unroll
  for (int c = 0; c < 9; ++c) a[c] = 0.f;
  const float* wp = p.w_ada + ((size_t)l * 1024 + kq * 256) * 3072 + col;
#pragma unroll 8
  for (int k = 0; k < 256; ++k) {
    float wv = wp[(size_t)k * 3072];
#pragma unroll
    for (int c = 0; c < 9; ++c) a[c] += sc[c * 1024 + kq * 256 + k] * wv;
  }
#pragma unroll
  for (int c = 0; c < 9; ++c) red[(kq * 9 + c) * 64 + (tid & 63)] = a[c];
  __syncthreads();
  float* mod = (float*)(p.ws + W_MOD);
  for (int i = tid; i < 9 * 64; i += 256) {
    int c = i >> 6, j = i & 63;
    float s = red[(0 * 9 + c) * 64 + j] + red[(1 * 9 + c) * 64 + j] + red[(2 * 9 + c) * 64 + j] + red[(3 * 9 + c) * 64 + j];
    mod[(size_t)(l * 9 + c) * 3072 + cb * 64 + j] = s + p.b_ada[l * 3072 + cb * 64 + j];
  }
}

DEV void cache_job(const P& p, int job, char* lds) {
  const int tid = ltid();
  const int bl = job >> 3, h = job & 7;
  bf16* CK = (bf16*)(p.ws + W_CK) + (size_t)job * 256 * 64;
  bf16* CV = (bf16*)(p.ws + W_CVT) + (size_t)job * 64 * 256;
  const float* ks = p.cache_na_k + (size_t)bl * 256 * 512 + h * 64;
  const float* vs = p.cache_na_v + (size_t)bl * 256 * 512 + h * 64;
  float* t = (float*)lds;
  __syncthreads();
  for (int i = tid; i < 256 * 16; i += 256) {
    int r = i >> 4, c4 = (i & 15) * 4;
    float4 kv = *(const float4*)(ks + (size_t)r * 512 + c4);
    uint2 o; o.x = pack2(kv.x, kv.y); o.y = pack2(kv.z, kv.w);
    *(uint2*)(CK + r * 64 + c4) = o;
    float4 vv = *(const float4*)(vs + (size_t)r * 512 + c4);
    t[r * 65 + c4] = vv.x; t[r * 65 + c4 + 1] = vv.y; t[r * 65 + c4 + 2] = vv.z; t[r * 65 + c4 + 3] = vv.w;
  }
  __syncthreads();
  for (int i = tid; i < 64 * 64; i += 256) {
    int e = i >> 6, t4 = (i & 63) * 4;
    uint2 o; o.x = pack2(t[(t4)*65 + e], t[(t4 + 1) * 65 + e]); o.y = pack2(t[(t4 + 2) * 65 + e], t[(t4 + 3) * 65 + e]);
    *(uint2*)(CV + e * 256 + t4) = o;
  }
}

DEV void h_job(const P& p, int l, int g0, int tb) {
  const int tid_ = ltid(); const int lane = tid_ & 63, w = tid_ >> 6;
  bf16* H = (bf16*)(p.ws + W_H);
  const float* mod = (const float*)(p.ws + W_MOD);
#pragma unroll
  for (int i = 0; i < 4; ++i) {
    int tl = tb * 16 + w * 4 + i, g = g0 + tl, cond = g >> 12;
    const float* x = xin_row(p, g);
    const float* md = mod + (size_t)(l * 9 + cond) * 3072;
#pragma unroll
    for (int j = 0; j < 4; ++j) {
      int col = lane * 4 + 256 * j;
      float4 xv = *(const float4*)(x + col), sh = *(const float4*)(md + col), sc = *(const float4*)(md + 1024 + col);
      uint2 o; o.x = pack2(xv.x * (1.f + sc.x) + sh.x, xv.y * (1.f + sc.y) + sh.y);
      o.y = pack2(xv.z * (1.f + sc.z) + sh.z, xv.w * (1.f + sc.w) + sh.w);
      *(uint2*)(H + (size_t)tl * 1024 + col) = o;
    }
  }
}

DEV void ln_job(const P& p, int l, int g0, int tb) {
  const int tid_ = ltid(); const int lane = tid_ & 63, w = tid_ >> 6;
  bf16* H = (bf16*)(p.ws + W_H);
  const float* mod = (const float*)(p.ws + W_MOD);
#pragma unroll
  for (int i = 0; i < 4; ++i) {
    int tl = tb * 16 + w * 4 + i, g = g0 + tl, cond = g >> 12;
    float* y = p.out + (size_t)g * 1024;
    float4 v[4];
    float s = 0.f;
#pragma unroll
    for (int j = 0; j < 4; ++j) { v[j] = *(const float4*)(y + lane * 4 + 256 * j); s += v[j].x + v[j].y + v[j].z + v[j].w; }
#pragma unroll
    for (int o = 32; o > 0; o >>= 1) s += __shfl_xor(s, o);
    float mu = s * (1.f / 1024.f), q = 0.f;
#pragma unroll
    for (int j = 0; j < 4; ++j) {
      v[j].x -= mu; v[j].y -= mu; v[j].z -= mu; v[j].w -= mu;
      q += v[j].x * v[j].x + v[j].y * v[j].y + v[j].z * v[j].z + v[j].w * v[j].w;
    }
#pragma unroll
    for (int o = 32; o > 0; o >>= 1) q += __shfl_xor(q, o);
    float rs = rsqrtf(q * (1.f / 1024.f) + EPS);
    const float* md = mod + (size_t)((l + 1) * 9 + cond) * 3072;
#pragma unroll
    for (int j = 0; j < 4; ++j) {
      int col = lane * 4 + 256 * j;
      float4 gg = *(const float4*)(p.ln_g + l * 1024 + col), bb = *(const float4*)(p.ln_b + l * 1024 + col);
      float4 o;
      o.x = v[j].x * rs * gg.x + bb.x; o.y = v[j].y * rs * gg.y + bb.y;
      o.z = v[j].z * rs * gg.z + bb.z; o.w = v[j].w * rs * gg.w + bb.w;
      *(float4*)(y + col) = o;
      if (l == 0) {
        float4 sh = *(const float4*)(md + col), sc = *(const float4*)(md + 1024 + col);
        uint2 hb; hb.x = pack2(o.x * (1.f + sc.x) + sh.x, o.y * (1.f + sc.y) + sh.y);
        hb.y = pack2(o.z * (1.f + sc.z) + sh.z, o.w * (1.f + sc.w) + sh.w);
        *(uint2*)(H + (size_t)tl * 1024 + col) = hb;
      }
    }
  }
}

DEV float rope_inv(int i) { return ex2(-(float)(i & 15) * (13.287712379549449f / 16.f)); }

DEV void mlaprep_job(const P& p, int l, int g0, int tb) {
  const int tid_ = ltid(); const int lane = tid_ & 63, w = tid_ >> 6;
  const bf16* Z = (const bf16*)(p.ws + W_Z);
  const float* KVPE = (const float*)(p.ws + W_KVPE);
  bf16* QN = (bf16*)(p.ws + W_QN);
  bf16* CKVB = (bf16*)(p.ws + W_CKVB);
  bf16* KPER = (bf16*)(p.ws + W_KPER);
  for (int i = 0; i < 8; ++i) {
    int tl = tb * 32 + w * 8 + i, g = g0 + tl, ug = tl >> 12, tu = tl & 4095;
    bool isctx = g < UT;
    uint2 qr = *(const uint2*)(Z + (size_t)tl * ZS + C_QD + lane * 4);
    float q0 = bf2f(qr.x & 0xffff), q1 = bf2f(qr.x >> 16), q2 = bf2f(qr.y & 0xffff), q3 = bf2f(qr.y >> 16);
    float ss = q0 * q0 + q1 * q1 + q2 * q2 + q3 * q3;
#pragma unroll
    for (int o = 32; o > 0; o >>= 1) ss += __shfl_xor(ss, o);
    float r = rsqrtf(ss * (1.f / 256.f) + EPS);
    float4 gq = *(const float4*)(p.qnorm_g + l * 256 + lane * 4);
    uint2 qo; qo.x = pack2(q0 * r * gq.x, q1 * r * gq.y); qo.y = pack2(q2 * r * gq.z, q3 * r * gq.w);
    *(uint2*)(QN + (size_t)tl * 256 + lane * 4) = qo;
    float2 kv = *(const float2*)(KVPE + (size_t)tl * 192 + lane * 2);
    float s2 = kv.x * kv.x + kv.y * kv.y;
#pragma unroll
    for (int o = 32; o > 0; o >>= 1) s2 += __shfl_xor(s2, o);
    float r2 = rsqrtf(s2 * (1.f / 128.f) + EPS);
    float2 gk = *(const float2*)(p.kvnorm_g + l * 128 + lane * 2);
    float c0 = kv.x * r2 * gk.x, c1 = kv.y * r2 * gk.y;
    *(unsigned*)(CKVB + ((size_t)ug * KVR + tu) * 128 + lane * 2) = pack2(c0, c1);
    if (isctx) {
      int b = g >> 8, t = g & 255;
      *(float2*)(p.out + O_CKV + ((size_t)(b * 2 + l) * 256 + t) * 128 + lane * 2) = make_float2(c0, c1);
    }
    float kp = KVPE[(size_t)tl * 192 + 128 + lane];
    float other = __shfl_xor(kp, 32);
    float ko = kp;
    if (!isctx) {
      int ii = lane & 31;
      float pos = ii < 16 ? (float)(tu >> 6) : (float)(tu & 63);
      float ang = pos * rope_inv(ii);
      float sn, cs;
      sincosf(ang, &sn, &cs);
      ko = lane < 32 ? kp * cs - other * sn : other * sn + kp * cs;
    }
    KPER[((size_t)ug * KVR + tu) * 64 + lane] = f2bf(ko);
  }
}

DEV void mlatail_job(const P& p, int l, int g0, int ug, int rb) {
  const int tid = ltid();
  const int b = ((g0 >> 12) + ug) - 1;
  bf16* CKVB = (bf16*)(p.ws + W_CKVB);
  bf16* KPER = (bf16*)(p.ws + W_KPER);
  for (int i = tid; i < 32 * 128; i += 256) {
    int r = rb * 32 + (i >> 7), c = i & 127;
    CKVB[((size_t)ug * KVR + UT + r) * 128 + c] = f2bf(p.cache_ckv[((size_t)(b * 2 + l) * 256 + r) * 128 + c]);
  }
  for (int i = tid; i < 32 * 64; i += 256) {
    int r = rb * 32 + (i >> 6), c = i & 63;
    KPER[((size_t)ug * KVR + UT + r) * 64 + c] = f2bf(p.cache_kpe[((size_t)(b * 2 + l) * 256 + r) * 64 + c]);
  }
}

DEV void conv_job(const P& p, int l, int g0, int tb) {
  const int tid = ltid();
  const bf16* Z = (const bf16*)(p.ws + W_Z);
  bf16* BR = (bf16*)(p.ws + W_BR);
  const int t0 = tb * 32, g = g0 + t0;
  const int L = g < UT ? 256 : 4096;
  const int pos0 = g & (L - 1);
  const int c = tid * 2;
  float2 w0 = *(const float2*)(p.conv_w + (l * 3 + 0) * 512 + c), w1 = *(const float2*)(p.conv_w + (l * 3 + 1) * 512 + c),
         w2 = *(const float2*)(p.conv_w + (l * 3 + 2) * 512 + c);
  auto ld2 = [&](int tl, int col) { unsigned u = *(const unsigned*)(Z + (size_t)tl * ZS + col + c); return make_float2(bf2f(u & 0xffff), bf2f(u >> 16)); };
  auto uu = [&](int tl) { float2 a = ld2(tl, C_DC), b = ld2(tl, C_DX); return make_float2(a.x * b.x, a.y * b.y); };
  float2 up = pos0 > 0 ? uu(t0 - 1) : make_float2(0.f, 0.f);
  float2 uc = uu(t0);
  for (int i = 0; i < 32; ++i) {
    int tl = t0 + i;
    float2 un = (pos0 + i < L - 1) ? uu(tl + 1) : make_float2(0.f, 0.f);
    float2 bb = ld2(tl, C_DB), gg = ld2(tl, C_DG);
    float o0 = bb.x * (w0.x * up.x + w1.x * uc.x + w2.x * un.x) * gg.x;
    float o1 = bb.y * (w0.y * up.y + w1.y * uc.y + w2.y * un.y) * gg.y;
    *(unsigned*)(BR + (size_t)tl * 2048 + 1536 + c) = pack2(o0, o1);
    up = uc; uc = un;
  }
}

DEV void stage_acc(const f32x16 (&acc)[2][2], char* lds) {
  const int tid_ = ltid(); const int lane = tid_ & 63, w = tid_ >> 6, wm = w >> 1, wn = w & 1, ll = lane & 31, hh = lane >> 5;
  float* t = (float*)lds;
#pragma unroll
  for (int mi = 0; mi < 2; ++mi)
#pragma unroll
    for (int ni = 0; ni < 2; ++ni)
#pragma unroll
      for (int reg = 0; reg < 16; ++reg)
        t[(wm * 64 + mi * 32 + rowoff(reg, hh)) * 132 + wn * 64 + ni * 32 + ll] = acc[mi][ni][reg];
  __syncthreads();
}
DEV uint4 pack8(const float* v) {
  uint4 u; u.x = pack2(v[0], v[1]); u.y = pack2(v[2], v[3]); u.z = pack2(v[4], v[5]); u.w = pack2(v[6], v[7]);
  return u;
}

DEV void gemm1_job(const P& p, int l, int g0, int mt, int n0, int ncap, char* lds) {
  const int tid = ltid();
  const int m0 = mt * 128;
  {
    f32x16 acc[2][2];
    zero16(acc[0][0]); zero16(acc[0][1]); zero16(acc[1][0]); zero16(acc[1][1]);
    const bf16* A = (const bf16*)(p.ws + W_H) + (size_t)m0 * 1024;
    const bf16* Bt = (const bf16*)(p.ws + W_WIN) + ((size_t)l * ZW + n0) * 1024;
    gemm_core<128>(acc, A, 1024, Bt, 1024, ncap - n0 < 128 ? ncap - n0 : 128, 1024, lds);
    stage_acc(acc, lds);
  }
  const float* t = (const float*)lds;
  bf16* Z = (bf16*)(p.ws + W_Z);
  const bool isctx = (g0 + m0) < UT;
  const int cc = (tid & 15) * 8, cb = n0 + cc;
  if (cb < ncap) {
    int mode;
    if (cb < C_AFF) mode = 1; else if (cb < C_AFB) mode = 3; else if (cb < C_AI) mode = 4; else if (cb < C_AG) mode = 0;
    else if (cb < C_BQ) mode = 1; else if (cb < C_BK) mode = 5; else if (cb < C_BV) mode = 6; else if (cb < C_BG) mode = 7;
    else if (cb < C_QD) mode = 1; else if (cb < C_KVD) mode = 0; else if (cb < C_KPE) mode = 8; else if (cb < C_CG) mode = 9;
    else if (cb < C_DB) mode = 1; else if (cb < C_DG) mode = 0; else if (cb < C_MG) mode = 1; else mode = 2;
    float bias[8], lbv[8];
#pragma unroll
    for (int j = 0; j < 8; ++j) { bias[j] = p.b_in[l * ZW + cb + j]; lbv[j] = 0.f; }
    if ((mode == 3 || mode == 4) && l > 0) {
      int dir = mode - 3, c = cb - (dir ? C_AFB : C_AFF);
#pragma unroll
      for (int j = 0; j < 8; ++j) lbv[j] = sigm(p.lb_logits[(dir * 2 + 1) * 512 + c + j] - p.lb_logits[(dir * 2 + 0) * 512 + c + j]);
    }
#pragma unroll 1
    for (int it = 0; it < 8; ++it) {
      const int rl = it * 16 + (tid >> 4), row = m0 + rl, g = g0 + row;
      float v[8];
      {
        float4 a0 = *(const float4*)(t + rl * 132 + cc), a1 = *(const float4*)(t + rl * 132 + cc + 4);
        v[0] = a0.x + bias[0]; v[1] = a0.y + bias[1]; v[2] = a0.z + bias[2]; v[3] = a0.w + bias[3];
        v[4] = a1.x + bias[4]; v[5] = a1.y + bias[5]; v[6] = a1.z + bias[6]; v[7] = a1.w + bias[7];
      }
      const size_t octx = (size_t)((g >> 8) * 2 + l) * 256 + (g & 255);
      switch (mode) {
        case 0: *(uint4*)(Z + (size_t)row * ZS + cb) = pack8(v); break;
        case 1: {
#pragma unroll
          for (int j = 0; j < 8; ++j) v[j] = silu(v[j]);
          *(uint4*)(Z + (size_t)row * ZS + cb) = pack8(v);
        } break;
        case 2: break;
        case 3:
        case 4: {
#pragma unroll
          for (int j = 0; j < 8; ++j)
            v[j] = (lbv[j] == 0.f) ? (fminf(v[j], 0.f) - __logf(1.f + __expf(-fabsf(v[j])))) : __logf(lbv[j] + (1.f - lbv[j]) * sigm(v[j]));
          _Float16* L = (_Float16*)(p.ws + (mode == 3 ? W_LGF : W_LGB)) + (size_t)row * 512 + (cb - (mode == 3 ? C_AFF : C_AFB));
          typedef _Float16 h8 __attribute__((ext_vector_type(8)));
          h8 hv;
#pragma unroll
          for (int j = 0; j < 8; ++j) hv[j] = (_Float16)v[j];
          *(h8*)L = hv;
        } break;
        case 5: {
#pragma unroll
          for (int j = 0; j < 8; ++j) v[j] *= QS_NA;
          *(uint4*)(Z + (size_t)row * ZS + cb) = pack8(v);
        } break;
        case 6:
        case 7: {
          if (mode == 6) *(uint4*)(Z + (size_t)row * ZS + cb) = pack8(v);
          if (isctx) {
            float* o = p.out + (mode == 6 ? O_NK : O_NV) + octx * 512 + (cb - (mode == 6 ? C_BK : C_BV));
            *(float4*)o = make_float4(v[0], v[1], v[2], v[3]);
            *(float4*)(o + 4) = make_float4(v[4], v[5], v[6], v[7]);
          }
        } break;
        case 8: {
          float* o = (float*)(p.ws + W_KVPE) + (size_t)row * 192 + (cb - C_KVD);
          *(float4*)o = make_float4(v[0], v[1], v[2], v[3]);
          *(float4*)(o + 4) = make_float4(v[4], v[5], v[6], v[7]);
        } break;
        case 9: {
          float* o = (float*)(p.ws + W_KVPE) + (size_t)row * 192 + 128 + (cb - C_KPE);
          *(float4*)o = make_float4(v[0], v[1], v[2], v[3]);
          *(float4*)(o + 4) = make_float4(v[4], v[5], v[6], v[7]);
          if (isctx) {
            float* o2 = p.out + O_KPE + octx * 64 + (cb - C_KPE);
            *(float4*)o2 = make_float4(v[0], v[1], v[2], v[3]);
            *(float4*)(o2 + 4) = make_float4(v[4], v[5], v[6], v[7]);
          }
        } break;
      }
    }
  }
  if (n0 >= C_MG) {
    bf16* GTt = (bf16*)(p.ws + W_G);
    const int c = tid & 127, rb = tid >> 7;
    const float bs = p.b_in[l * ZW + n0 + c];
#pragma unroll 1
    for (int i = 0; i < 8; ++i) {
      float v[8];
#pragma unroll
      for (int j = 0; j < 8; ++j) v[j] = sigm(t[(rb * 64 + i * 8 + j) * 132 + c] + bs);
      *(uint4*)(GTt + (size_t)(n0 - C_MG + c) * GT + m0 + rb * 64 + i * 8) = pack8(v);
    }
  }
  if (n0 >= C_BV && n0 < C_BG) {
    bf16* NVT = (bf16*)(p.ws + W_NVT);
    const int c = tid & 127, rb = tid >> 7;
    const float bs = p.b_in[l * ZW + n0 + c];
#pragma unroll 1
    for (int i = 0; i < 8; ++i) {
      float v[8];
#pragma unroll
      for (int j = 0; j < 8; ++j) v[j] = t[(rb * 64 + i * 8 + j) * 132 + c] + bs;
      *(uint4*)(NVT + (size_t)(n0 - C_BV + c) * GT + m0 + rb * 64 + i * 8) = pack8(v);
    }
  }
}

DEV void gemmq_job(const P& p, int l, int g0, int mt, int nt, char* lds) {
  const int tid_ = ltid(); const int lane = tid_ & 63, w = tid_ >> 6, wm = w >> 1, wn = w & 1, ll = lane & 31, hh = lane >> 5;
  f32x16 acc[2][2];
  zero16(acc[0][0]); zero16(acc[0][1]); zero16(acc[1][0]); zero16(acc[1][1]);
  const int m0 = mt * 128, n0 = nt * 128;
  gemm_core<128>(acc, (const bf16*)(p.ws + W_QN) + (size_t)m0 * 256, 256,
                 (const bf16*)(p.ws + W_WQB) + ((size_t)l * 768 + n0) * 256, 256, 128, 256, lds);
  bf16* QM = (bf16*)(p.ws + W_QM);
  const bool isctx = (g0 + m0) < UT;
  const int cbase = n0 + wn * 64;
  const bool rope = (!isctx) && ((cbase % 192) == 128);
  const float inv = rope_inv(ll);
#pragma unroll
  for (int mi = 0; mi < 2; ++mi) {
#pragma unroll
    for (int reg = 0; reg < 16; ++reg) {
      const int row = m0 + wm * 64 + mi * 32 + rowoff(reg, hh);
      float x1 = acc[mi][0][reg] * QS_MLA, x2 = acc[mi][1][reg] * QS_MLA;
      if (rope) {
        int tu = row & 4095;
        float pos = ll < 16 ? (float)(tu >> 6) : (float)(tu & 63);
        float sn, cs;
        sincosf(pos * inv, &sn, &cs);
        float y1 = x1 * cs - x2 * sn, y2 = x1 * sn + x2 * cs;
        x1 = y1; x2 = y2;
      }
      QM[(size_t)row * 768 + cbase + ll] = f2bf(x1);
      QM[(size_t)row * 768 + cbase + 32 + ll] = f2bf(x2);
    }
  }
}

DEV void gemmkv_job(const P& p, int l, int ug, int mt, int nt, char* lds) {
  const int tid_ = ltid(); const int lane = tid_ & 63, w = tid_ >> 6, wm = w >> 1, wn = w & 1, ll = lane & 31, hh = lane >> 5;
  f32x16 acc[2][2];
  zero16(acc[0][0]); zero16(acc[0][1]); zero16(acc[1][0]); zero16(acc[1][1]);
  const int m0 = mt * 128, n0 = nt * 128;
  gemm_core<128>(acc, (const bf16*)(p.ws + W_CKVB) + ((size_t)ug * KVR + m0) * 128, 128,
                 (const bf16*)(p.ws + W_WKVB) + ((size_t)l * 1024 + n0) * 128, 128, 128, 128, lds);
  bf16* KN = (bf16*)(p.ws + W_KN);
  bf16* VT = (bf16*)(p.ws + W_VT);
  const int hd = n0 >> 8;
  const bool isv = (n0 & 255) != 0;
#pragma unroll
  for (int mi = 0; mi < 2; ++mi)
#pragma unroll
    for (int ni = 0; ni < 2; ++ni) {
      const int cw = wn * 64 + ni * 32 + ll;
      const int rbase = m0 + wm * 64 + mi * 32;
      if (!isv) {
#pragma unroll
        for (int reg = 0; reg < 16; ++reg)
          KN[((size_t)ug * KVR + rbase + rowoff(reg, hh)) * 512 + hd * 128 + cw] = f2bf(acc[mi][ni][reg]);
      } else {
#pragma unroll
        for (int g4 = 0; g4 < 4; ++g4) {
          uint2 o; o.x = pack2(acc[mi][ni][4 * g4], acc[mi][ni][4 * g4 + 1]); o.y = pack2(acc[mi][ni][4 * g4 + 2], acc[mi][ni][4 * g4 + 3]);
          *(uint2*)(VT + ((size_t)ug * 512 + hd * 128 + cw) * KVR + rbase + 8 * g4 + 4 * hh) = o;
        }
      }
    }
}

DEV void gemm3_job(const P& p, int l, int mt, int nt, char* lds) {
  constexpr int STAGE = 256 * 128;
  const int tid = ltid(), lane = tid & 63, w = tid >> 6, wm = w >> 1, wn = w & 1, ll = lane & 31, hh = lane >> 5;
  const int m0 = mt * 128, n0 = nt * 128;
  f32x16 ms[2][2], acc[2][2];
  unsigned gp[2][2][8];
#pragma unroll
  for (int mi = 0; mi < 2; ++mi)
#pragma unroll
    for (int ni = 0; ni < 2; ++ni) { zero16(ms[mi][ni]); zero16(acc[mi][ni]); }
  const int lrow = tid >> 3, lch = (tid & 7) ^ ((tid >> 4) & 7);
  const bf16* aH = (const bf16*)(p.ws + W_H) + (size_t)(m0 + lrow) * 1024 + lch * 8;
  const bf16* aB = (const bf16*)(p.ws + W_BR) + (size_t)(m0 + lrow) * 2048 + lch * 8;
  const bf16* bG = (const bf16*)(p.ws + W_WIN) + ((size_t)l * ZW + C_MG + n0 + lrow) * 1024 + lch * 8;
  const bf16* bB = (const bf16*)(p.ws + W_WBR) + ((size_t)l * 1024 + n0 + lrow) * 2048 + lch * 8;
  char* ldst = lds + tid * 16;
  auto issue = [&](int kt, int st) {
    const int n = kt / 24, r = kt - n * 24;
    char* d = ldst + st * STAGE;
    if (r < 16) {
      const bf16* ap = aH + r * 64;
      const bf16* bp = bG + (size_t)n * 1024 * 1024 + r * 64;
#pragma unroll
      for (int i = 0; i < 4; ++i)
        __builtin_amdgcn_global_load_lds((const unsigned*)(ap + (size_t)(32 * i) * 1024), (__attribute__((address_space(3))) unsigned*)(d + i * 4096), 16, 0, 0);
#pragma unroll
      for (int i = 0; i < 4; ++i)
        __builtin_amdgcn_global_load_lds((const unsigned*)(bp + (size_t)(32 * i) * 1024), (__attribute__((address_space(3))) unsigned*)(d + 16384 + i * 4096), 16, 0, 0);
    } else {
      const bf16* ap = aB + n * 512 + (r - 16) * 64;
      const bf16* bp = bB + n * 512 + (r - 16) * 64;
#pragma unroll
      for (int i = 0; i < 4; ++i)
        __builtin_amdgcn_global_load_lds((const unsigned*)(ap + (size_t)(32 * i) * 2048), (__attribute__((address_space(3))) unsigned*)(d + i * 4096), 16, 0, 0);
#pragma unroll
      for (int i = 0; i < 4; ++i)
        __builtin_amdgcn_global_load_lds((const unsigned*)(bp + (size_t)(32 * i) * 2048), (__attribute__((address_space(3))) unsigned*)(d + 16384 + i * 4096), 16, 0, 0);
    }
  };
  const int key = (ll >> 1) & 7;
  int koff[4];
#pragma unroll
  for (int ks = 0; ks < 4; ++ks) koff[ks] = ((2 * ks + hh) ^ key) * 16;
  __syncthreads();
  issue(0, 0);
  asm volatile("s_waitcnt vmcnt(0)" ::: "memory");
  __syncthreads();
  int kt = 0;
  auto step = [&]() {
    if (kt + 1 < 96) issue(kt + 1, (kt + 1) & 1);
    const char* s = lds + (kt & 1) * STAGE;
    const char* sa = s + (wm * 64 + ll) * 128;
    const char* sb = s + 16384 + (wn * 64 + ll) * 128;
#pragma unroll
    for (int ks = 0; ks < 4; ++ks) {
      bf16x8 a0 = *(const bf16x8*)(sa + koff[ks]), a1 = *(const bf16x8*)(sa + 32 * 128 + koff[ks]);
#pragma unroll
      for (int ni = 0; ni < 2; ++ni) {
        bf16x8 bq = *(const bf16x8*)(sb + ni * 32 * 128 + koff[ks]);
        acc[0][ni] = MFMA(a0, bq, acc[0][ni]);
        acc[1][ni] = MFMA(a1, bq, acc[1][ni]);
      }
    }
    __builtin_amdgcn_sched_group_barrier(0x100, 8, 0);
    __builtin_amdgcn_sched_group_barrier(0x008, 4, 0);
    __builtin_amdgcn_sched_group_barrier(0x100, 4, 0);
    __builtin_amdgcn_sched_group_barrier(0x008, 4, 0);
    __builtin_amdgcn_sched_group_barrier(0x100, 4, 0);
    __builtin_amdgcn_sched_group_barrier(0x008, 8, 0);
    asm volatile("s_waitcnt vmcnt(0)" ::: "memory");
    __syncthreads();
    ++kt;
  };
#pragma unroll 1
  for (int n = 0; n < 4; ++n) {
#pragma unroll 1
    for (int r = 0; r < 16; ++r) step();
#pragma unroll
    for (int ni = 0; ni < 2; ++ni) {
      const float bias = p.b_in[l * ZW + C_MG + n * 1024 + n0 + wn * 64 + ni * 32 + ll];
#pragma unroll
      for (int mi = 0; mi < 2; ++mi)
#pragma unroll
        for (int k = 0; k < 8; ++k) {
          gp[mi][ni][k] = pack2(sigm(acc[mi][ni][2 * k] + bias), sigm(acc[mi][ni][2 * k + 1] + bias));
          acc[mi][ni][2 * k] = 0.f; acc[mi][ni][2 * k + 1] = 0.f;
        }
    }
#pragma unroll 1
    for (int r = 0; r < 8; ++r) step();
#pragma unroll
    for (int mi = 0; mi < 2; ++mi)
#pragma unroll
      for (int ni = 0; ni < 2; ++ni)
#pragma unroll
        for (int k = 0; k < 8; ++k) {
          ms[mi][ni][2 * k] += bf2f(gp[mi][ni][k] & 0xffff) * acc[mi][ni][2 * k];
          ms[mi][ni][2 * k + 1] += bf2f(gp[mi][ni][k] >> 16) * acc[mi][ni][2 * k + 1];
          acc[mi][ni][2 * k] = 0.f; acc[mi][ni][2 * k + 1] = 0.f;
        }
  }
  bf16* MB = (bf16*)(p.ws + W_MB);
  stage_acc(ms, lds);
  {
    const float* t = (const float*)lds;
    const int cc = (tid & 15) * 8;
#pragma unroll 1
    for (int it = 0; it < 8; ++it) {
      const int rl = it * 16 + (tid >> 4);
      float v[8];
      float4 a0 = *(const float4*)(t + rl * 132 + cc), a1 = *(const float4*)(t + rl * 132 + cc + 4);
      v[0] = a0.x; v[1] = a0.y; v[2] = a0.z; v[3] = a0.w; v[4] = a1.x; v[5] = a1.y; v[6] = a1.z; v[7] = a1.w;
      *(uint4*)(MB + (size_t)(m0 + rl) * 1024 + n0 + cc) = pack8(v);
    }
  }
}

DEV void gemm4_job(const P& p, int l, int g0, int mt, int nt, char* lds) {
  const int tid = ltid();
  const int m0 = mt * 128, n0 = nt * 128;
  {
    f32x16 acc[2][2];
    zero16(acc[0][0]); zero16(acc[0][1]); zero16(acc[1][0]); zero16(acc[1][1]);
    gemm_core<128>(acc, (const bf16*)(p.ws + W_MB) + (size_t)m0 * 1024, 1024,
                   (const bf16*)(p.ws + W_WOUT) + ((size_t)l * 1024 + n0) * 1024, 1024, 128, 1024, lds);
    stage_acc(acc, lds);
  }
  const float* t = (const float*)lds;
  const int cond = (g0 + m0) >> 12;
  const int cc = (tid & 31) * 4;
  const float4 gt = *(const float4*)((const float*)(p.ws + W_MOD) + (size_t)(l * 9 + cond) * 3072 + 2048 + n0 + cc);
#pragma unroll 1
  for (int it = 0; it < 16; ++it) {
    const int rl = it * 8 + (tid >> 5), g = g0 + m0 + rl;
    float* y = p.out + (size_t)g * 1024 + n0 + cc;
    const float4 xv = l == 0 ? *(const float4*)(xin_row(p, g) + n0 + cc) : *(const float4*)y;
    const float4 a = *(const float4*)(t + rl * 132 + cc);
    *(float4*)y = make_float4(ALPHA * xv.x + gt.x * a.x, ALPHA * xv.y + gt.y * a.y, ALPHA * xv.z + gt.z * a.z, ALPHA * xv.w + gt.w * a.w);
  }
}

template <int ET>
DEV void smax32(f32x16& x, float& m, float& lsum, f32x16 (&o)[ET]) {
  float mx = x[0];
#pragma unroll
  for (int i = 1; i < 16; ++i) mx = fmaxf(mx, x[i]);
  mx = xhalf_max(mx);
  if (__any(mx > m + 8.f)) {
    float mn = fmaxf(m, mx), al_ = ex2(m - mn);
    m = mn;
    lsum *= al_;
#pragma unroll
    for (int e = 0; e < ET; ++e)
#pragma unroll
      for (int i = 0; i < 16; ++i) o[e][i] *= al_;
  }
  float ps = 0.f;
#pragma unroll
  for (int i = 0; i < 16; ++i) { x[i] = ex2(x[i] - m); ps += x[i]; }
  lsum += ps;
}

DEV void na_wave(const P& p, int l, int g0, int ug, int qb, int h, char* lds) {
  const int tid_ = ltid(); const int lane = tid_ & 63, ll = lane & 31, hh = lane >> 5;
  float* bt = (float*)(lds + (tid_ >> 6) * 2048);
  const bf16* Z = (const bf16*)(p.ws + W_Z);
  const bf16* NVT = (const bf16*)(p.ws + W_NVT);
  const int ub = ug * UT;
  const bool isctx = (g0 + ub) < UT;
  const int tq = ub + qb * 32 + ll;
  bf16x8 qf[4];
  {
    const bf16* qp = Z + (size_t)tq * ZS + C_BQ + h * 64 + hh * 8;
#pragma unroll
    for (int ks = 0; ks < 4; ++ks) qf[ks] = *(const bf16x8*)(qp + ks * 16);
  }
  f32x16 o[2];
  zero16(o[0]); zero16(o[1]);
  float m = -1e30f, lsum = 0.f;
  const bf16 *kb, *vb;
  size_t kstride, vstride;
  if (isctx) {
    int kt0 = ub + ((qb * 32) & ~255);
    kb = Z + (size_t)kt0 * ZS + C_BK + h * 64; kstride = ZS;
    vb = NVT + (size_t)(h * 64) * GT + kt0; vstride = GT;
  } else {
    int b = ((g0 >> 12) + ug) - 1;
    kb = (const bf16*)(p.ws + W_CK) + (size_t)((b * 2 + l) * 8 + h) * 256 * 64; kstride = 64;
    vb = (const bf16*)(p.ws + W_CVT) + (size_t)((b * 2 + l) * 8 + h) * 64 * 256; vstride = 256;
  }
  const int r = qb >> 1, c = (qb & 1) * 32 + ll;
  int rs = r - 4; rs = rs < 0 ? 0 : (rs > 56 ? 56 : rs);
  int cs = c - 8; cs = cs < 0 ? 0 : (cs > 48 ? 48 : cs);
  const float* rpb = p.na_rpb + (size_t)(l * 8 + h) * 15 * 31;
  if (!isctx) {
    for (int i = lane; i < 465; i += 64) bt[i] = rpb[i] * LOG2E;
  }
  const int nt = isctx ? 8 : 24;
  char* kl = lds + 8192 + (tid_ >> 6) * 8192;
  char* vl = kl + 4096;
  const int krow = lane >> 3, kch = lane & 7, vrow = lane >> 2, vch = lane & 3;
  uint4 kr0, kr1, kr2, kr3, vr0, vr1, vr2, vr3;
#define NA_LOAD(i_)                                                                                        \
  {                                                                                                        \
    const bf16 *kp_, *vp_;                                                                                 \
    size_t ks_, vs_;                                                                                       \
    if ((i_) < 8) { kp_ = kb + (size_t)((i_) * 32) * kstride; ks_ = kstride; vp_ = vb + (i_) * 32; vs_ = vstride; } \
    else {                                                                                                 \
      const int j_ = (i_) - 8, kt0_ = ub + (rs + (j_ >> 1)) * 64 + (j_ & 1) * 32;                          \
      kp_ = Z + (size_t)kt0_ * ZS + C_BK + h * 64; ks_ = ZS;                                               \
      vp_ = NVT + (size_t)(h * 64) * GT + kt0_; vs_ = GT;                                                  \
    }                                                                                                      \
    kp_ += (size_t)krow * ks_ + kch * 8; vp_ += (size_t)vrow * vs_ + vch * 8;                              \
    kr0 = *(const uint4*)(kp_); kr1 = *(const uint4*)(kp_ + 8 * ks_);                                      \
    kr2 = *(const uint4*)(kp_ + 16 * ks_); kr3 = *(const uint4*)(kp_ + 24 * ks_);                          \
    vr0 = *(const uint4*)(vp_); vr1 = *(const uint4*)(vp_ + 16 * vs_);                                     \
    vr2 = *(const uint4*)(vp_ + 32 * vs_); vr3 = *(const uint4*)(vp_ + 48 * vs_);                          \
  }
  const int kw0 = krow * 128, kx_ = krow >> 1, vw0 = vrow * 64 + ((vch ^ ((vrow >> 2) & 3)) << 4);
  const int kfo = ll * 128, kfx = (ll >> 1) & 7, vfx = (ll >> 2) & 3;
  NA_LOAD(0)
  for (int i = 0; i < nt; ++i) {
    *(uint4*)(kl + kw0 + ((kch ^ (kx_ & 7)) << 4)) = kr0;
    *(uint4*)(kl + kw0 + 1024 + ((kch ^ ((kx_ + 4) & 7)) << 4)) = kr1;
    *(uint4*)(kl + kw0 + 2048 + ((kch ^ (kx_ & 7)) << 4)) = kr2;
    *(uint4*)(kl + kw0 + 3072 + ((kch ^ ((kx_ + 4) & 7)) << 4)) = kr3;
    *(uint4*)(vl + vw0) = vr0; *(uint4*)(vl + vw0 + 1024) = vr1; *(uint4*)(vl + vw0 + 2048) = vr2; *(uint4*)(vl + vw0 + 3072) = vr3;
    { const int inx = i + 1 < nt ? i + 1 : i; NA_LOAD(inx) }
    f32x16 x;
    zero16(x);
#pragma unroll
    for (int ks = 0; ks < 4; ++ks) x = MFMA(*(const bf16x8*)(kl + kfo + (((2 * ks + hh) ^ kfx) << 4)), qf[ks], x);
    if (i >= 8) {
      const int j8 = i - 8, half = j8 & 1, kr = rs + (j8 >> 1);
      const float* rp = bt + (kr - r + 7) * 31 + 15 - c;
#pragma unroll
      for (int reg = 0; reg < 16; ++reg) {
        int j = half * 32 + rowoff(reg, hh);
        bool ok = (j >= cs) && (j < cs + 16);
        int jc = j < c - 15 ? c - 15 : (j > c + 15 ? c + 15 : j);
        x[reg] = x[reg] + rp[jc] + (ok ? 0.f : -1e30f);
      }
    }
    smax32<2>(x, m, lsum, o);
#pragma unroll
    for (int s2 = 0; s2 < 2; ++s2) {
      bf16x8 pf = packf8(x, s2);
#pragma unroll
      for (int e = 0; e < 2; ++e) {
        const char* vp = vl + (e * 32 + ll) * 64 + 8 * hh;
        o[e] = MFMA(comb(*(const uint2*)(vp + (((2 * s2) ^ vfx) << 4)), *(const uint2*)(vp + (((2 * s2 + 1) ^ vfx) << 4))), pf, o[e]);
      }
    }
  }
  float lt = lsum + __shfl_xor(lsum, 32);
  float inv = 1.f / lt;
  bf16* BR = (bf16*)(p.ws + W_BR);
#pragma unroll
  for (int e = 0; e < 2; ++e)
#pragma unroll
    for (int g4 = 0; g4 < 4; ++g4) {
      int ee = h * 64 + e * 32 + 8 * g4 + 4 * hh;
      uint2 gr = *(const uint2*)(Z + (size_t)tq * ZS + C_BG + ee);
      uint2 ov;
      ov.x = pack2(o[e][4 * g4] * inv * bf2f(gr.x & 0xffff), o[e][4 * g4 + 1] * inv * bf2f(gr.x >> 16));
      ov.y = pack2(o[e][4 * g4 + 2] * inv * bf2f(gr.y & 0xffff), o[e][4 * g4 + 3] * inv * bf2f(gr.y >> 16));
      *(uint2*)(BR + (size_t)tq * 2048 + 512 + ee) = ov;
    }
}

DEV void mla_job(const P& p, int g0, int ug, int qblk, int h, char* lds) {
  const int tid = ltid(), lane = tid & 63, w = tid >> 6, ll = lane & 31, hh = lane >> 5;
  const int ub = ug * UT;
  const bool isctx = (g0 + ub) < UT;
  const int tq = ub + qblk * 128 + w * 32 + ll;
  bf16x8 qf[12];
  {
    const bf16* qp = (const bf16*)(p.ws + W_QM) + (size_t)tq * 768 + h * 192 + hh * 8;
#pragma unroll
    for (int ks = 0; ks < 12; ++ks) qf[ks] = *(const bf16x8*)(qp + ks * 16);
  }
  const int key_lo = isctx ? (qblk >> 1) * 256 : 0, ntiles = isctx ? 8 : 136;
  const bf16* KNb = (const bf16*)(p.ws + W_KN) + (size_t)ug * KVR * 512 + h * 128;
  const bf16* KPb = (const bf16*)(p.ws + W_KPER) + (size_t)ug * KVR * 64;
  const bf16* VTb = (const bf16*)(p.ws + W_VT) + ((size_t)ug * 512 + h * 128) * KVR;
  const bf16* kptr[3];
  int kstr[3];
#pragma unroll
  for (int i = 0; i < 3; ++i) {
    int L = tid * 16 + i * 4096, row = L / 384, pos = (L - row * 384) >> 4, c = pos ^ ((row >> 1) & 7);
    if (c < 16) { kptr[i] = KNb + (size_t)(key_lo + row) * 512 + c * 8; kstr[i] = 32 * 512; }
    else { kptr[i] = KPb + (size_t)(key_lo + row) * 64 + (c - 16) * 8; kstr[i] = 32 * 64; }
  }
  const bf16* vptr[2];
#pragma unroll
  for (int i = 0; i < 2; ++i) {
    int e = (tid >> 2) + 64 * i, c = (tid & 3) ^ ((tid >> 4) & 3);
    vptr[i] = VTb + (size_t)e * KVR + key_lo + c * 8;
  }
  char* ldst = lds + tid * 16;
#define MLA_ISSUE(t)                                                                                                         \
  {                                                                                                                          \
    const int ks_ = (t) % 3, vs_ = (t) & 3;                                                                                  \
    _Pragma("unroll") for (int i = 0; i < 3; ++i) __builtin_amdgcn_global_load_lds(                                          \
        (const unsigned*)(kptr[i] + (size_t)(t) * kstr[i]), (__attribute__((address_space(3))) unsigned*)(ldst + ks_ * 12288 + i * 4096), 16, 0, 0); \
    _Pragma("unroll") for (int i = 0; i < 2; ++i) __builtin_amdgcn_global_load_lds(                                          \
        (const unsigned*)(vptr[i] + (size_t)(t) * 32), (__attribute__((address_space(3))) unsigned*)(ldst + 36864 + vs_ * 8192 + i * 4096), 16, 0, 0); \
  }
#define MLA_S(xout, t)                                                                                                       \
  {                                                                                                                          \
    const char* S_ = lds + ((t) % 3) * 12288;                                                                                \
    zero16(xout);                                                                                                            \
    _Pragma("unroll") for (int ks = 0; ks < 12; ++ks)                                                                        \
      xout = MFMA(*(const bf16x8*)(S_ + (ks >> 2) * 128 + klo[ks & 3]), qf[ks], xout);                                       \
  }
  const int kx = (ll >> 1) & 7, vx = (ll >> 2) & 3;
  int klo[4];
#pragma unroll
  for (int ks = 0; ks < 4; ++ks) klo[ks] = ll * 384 + (((2 * ks + hh) ^ kx) << 4);
  int vo[4];
#pragma unroll
  for (int c = 0; c < 4; ++c) vo[c] = 36864 + ll * 64 + ((c ^ vx) << 4) + 8 * hh;
  f32x16 o[4];
  zero16(o[0]); zero16(o[1]); zero16(o[2]); zero16(o[3]);
  float m = -1e30f, lsum = 0.f;
  const unsigned lds_base = lds_addr(lds);
  __syncthreads();
  MLA_ISSUE(0)
  MLA_ISSUE(1)
  MLA_ISSUE(2)
  asm volatile("s_waitcnt vmcnt(12)" ::: "memory");
  __builtin_amdgcn_s_barrier();
  f32x16 x;
  MLA_S(x, 0)
  for (int t = 0; t < ntiles; ++t) {
    if (t + 2 < ntiles) asm volatile("s_waitcnt vmcnt(7)" ::: "memory");
    else if (t + 1 < ntiles) asm volatile("s_waitcnt vmcnt(2)" ::: "memory");
    else asm volatile("s_waitcnt vmcnt(0)" ::: "memory");
    __builtin_amdgcn_s_barrier();
    if (t + 3 < ntiles) MLA_ISSUE(t + 3)
    f32x16 xn;
    if (t + 1 < ntiles) MLA_S(xn, t + 1)
    float mx = x[0];
#pragma unroll
    for (int i = 1; i < 16; ++i) mx = fmaxf(mx, x[i]);
    mx = xhalf_max(mx);
    if (__any(mx > m + 8.f)) {
      float mn = fmaxf(m, mx), al_ = ex2(m - mn);
      m = mn;
      lsum *= al_;
#pragma unroll
      for (int e = 0; e < 4; ++e)
#pragma unroll
        for (int i = 0; i < 16; ++i) o[e][i] *= al_;
    }
    float ps = 0.f;
#pragma unroll
    for (int i = 0; i < 16; ++i) { x[i] = ex2(x[i] - m); ps += x[i]; }
    lsum += ps;
    const unsigned vb_ = lds_base + (t & 3) * 8192;
#pragma unroll
    for (int s = 0; s < 2; ++s) {
      u32x2 vr[4][2];
#pragma unroll
      for (int e = 0; e < 4; ++e) { vr[e][0] = lds_rd64(vb_ + e * 2048 + vo[2 * s]); vr[e][1] = lds_rd64(vb_ + e * 2048 + vo[2 * s + 1]); }
      bf16x8 pf = packf8(x, s);
      asm volatile("s_waitcnt lgkmcnt(0)"
                   : "+v"(vr[0][0]), "+v"(vr[0][1]), "+v"(vr[1][0]), "+v"(vr[1][1]), "+v"(vr[2][0]), "+v"(vr[2][1]), "+v"(vr[3][0]), "+v"(vr[3][1]));
#pragma unroll
      for (int e = 0; e < 4; ++e) o[e] = MFMA(comb2(vr[e][0], vr[e][1]), pf, o[e]);
    }
    if (t + 1 < ntiles) {
#pragma unroll
      for (int i = 0; i < 16; ++i) x[i] = xn[i];
    }
  }
  float lt = lsum + __shfl_xor(lsum, 32);
  float inv = 1.f / lt;
  const bf16* Z = (const bf16*)(p.ws + W_Z);
  bf16* BR = (bf16*)(p.ws + W_BR);
#pragma unroll
  for (int e = 0; e < 4; ++e)
#pragma unroll
    for (int g4 = 0; g4 < 4; ++g4) {
      int ee = h * 128 + e * 32 + 8 * g4 + 4 * hh;
      uint2 gr = *(const uint2*)(Z + (size_t)tq * ZS + C_CG + ee);
      uint2 ov;
      ov.x = pack2(o[e][4 * g4] * inv * bf2f(gr.x & 0xffff), o[e][4 * g4 + 1] * inv * bf2f(gr.x >> 16));
      ov.y = pack2(o[e][4 * g4 + 2] * inv * bf2f(gr.y & 0xffff), o[e][4 * g4 + 3] * inv * bf2f(gr.y >> 16));
      *(uint2*)(BR + (size_t)tq * 2048 + 1024 + ee) = ov;
    }
}

#define HG_SCAN(LGPTR)                                                                     \
  float lgv[32];                                                                           \
  _Pragma("unroll") for (int r = 0; r < 32; ++r) lgv[r] = (LGPTR)[(size_t)r * 512];        \
  {                                                                                        \
    float run = 0.f;                                                                       \
    _Pragma("unroll") for (int r = 0; r < 32; ++r) run += lgv[r];                          \
    sTot[hf * 128 + d] = run;                                                              \
  }                                                                                        \
  __syncthreads();                                                                         \
  const float t0_ = sTot[d], t1_ = sTot[128 + d], tot = t0_ + t1_;                         \
  const float cm = dir == 0 ? t0_ : t1_;                                                   \
  float bb = dir == 0 ? (hf == 1 ? t0_ : 0.f) : (hf == 0 ? t1_ : 0.f);

#define HG_SCAN2(LGPTR)                                                                    \
  {                                                                                        \
    float run = 0.f;                                                                       \
    _Pragma("unroll 16") for (int r = 0; r < 32; ++r) run += (LGPTR)[(size_t)r * 512];     \
    sTot[hf * 128 + d] = run;                                                              \
  }                                                                                        \
  __syncthreads();                                                                         \
  const float t0_ = sTot[d], t1_ = sTot[128 + d];                                          \
  const float cm = dir == 0 ? t0_ : t1_;                                                   \
  float bb = dir == 0 ? (hf == 1 ? t0_ : 0.f) : (hf == 0 ? t1_ : 0.f);

DEV void hgrn_a(const P& p, int cid, int h, int dir, char* lds) {
  const int tid = ltid(), lane = tid & 63, w = tid >> 6, ll = lane & 31, hh = lane >> 5;
  const int d = tid & 127, hf = tid >> 7;
  bf16* kT = (bf16*)lds;
  bf16* vT = (bf16*)(lds + 128 * 144);
  float* sTot = (float*)(lds + 2 * 128 * 144);
  const int tl0 = cid * 64 + hf * 32;
  const int idx = (cid * 4 + h) * 2 + dir;
  const _Float16* LG = (const _Float16*)(p.ws + (dir ? W_LGB : W_LGF)) + (size_t)tl0 * 512 + h * 128 + d;
  __syncthreads();
  HG_SCAN(LG)
  {
    const bf16* vp = (const bf16*)(p.ws + W_Z) + (size_t)tl0 * ZS + C_AI + h * 128 + d;
    bf16 vv[32];
#pragma unroll
    for (int r = 0; r < 32; ++r) vv[r] = vp[(size_t)r * ZS];
    if (dir == 0) {
#pragma unroll
      for (int r = 0; r < 32; ++r) { const float lg = lgv[r]; bb += lg; kT[d * 72 + hf * 32 + r] = f2bf(-expm1f(lg) * __expf(tot - bb)); }
    } else {
#pragma unroll
      for (int r = 31; r >= 0; --r) { const float lg = lgv[r]; bb += lg; kT[d * 72 + hf * 32 + r] = f2bf(-expm1f(lg) * __expf(tot - bb)); }
    }
#pragma unroll
    for (int r = 0; r < 32; ++r) vT[d * 72 + hf * 32 + r] = vv[r];
  }
  if (hf == 0) {
    ((float*)(p.ws + W_BL))[(size_t)idx * 128 + d] = tot;
    ((float*)(p.ws + W_CM))[(size_t)idx * 128 + d] = cm;
  }
  __syncthreads();
  f32x16 acc[4];
  zero16(acc[0]); zero16(acc[1]); zero16(acc[2]); zero16(acc[3]);
#pragma unroll
  for (int ks = 0; ks < 4; ++ks) {
    bf16x8 a = *(const bf16x8*)(vT + (w * 32 + ll) * 72 + ks * 16 + hh * 8);
#pragma unroll
    for (int it = 0; it < 4; ++it) acc[it] = MFMA(a, *(const bf16x8*)(kT + (it * 32 + ll) * 72 + ks * 16 + hh * 8), acc[it]);
  }
  bf16* SU = (bf16*)(p.ws + W_SU) + (size_t)idx * 16384;
#pragma unroll
  for (int it = 0; it < 4; ++it)
#pragma unroll
    for (int reg = 0; reg < 16; ++reg) SU[(w * 32 + rowoff(reg, hh)) * 128 + it * 32 + ll] = f2bf(acc[it][reg]);
}

template <int UN>
DEV void hgrn_b(const P& p, int l, int cbase, int NC, int h, int dir, int es, const float* s0, float* sout, char* lds) {
  const int tid = ltid();
  const int e = es * 16 + (tid >> 4), i0 = (tid & 15) * 8;
  float S[8];
  float* tb_ = (float*)lds;
  const int ti_ = tid >> 1, th_ = (tid & 1) * 8;
  if (s0) {
    const float4 a0 = *(const float4*)(s0 + (size_t)ti_ * 128 + es * 16 + th_), a1 = *(const float4*)(s0 + (size_t)ti_ * 128 + es * 16 + th_ + 4);
    float* d = tb_ + ti_ * 17 + th_;
    d[0] = a0.x; d[1] = a0.y; d[2] = a0.z; d[3] = a0.w; d[4] = a1.x; d[5] = a1.y; d[6] = a1.z; d[7] = a1.w;
    __syncthreads();
#pragma unroll
    for (int j = 0; j < 8; ++j) S[j] = tb_[(i0 + j) * 17 + (tid >> 4)];
  } else {
#pragma unroll
    for (int j = 0; j < 8; ++j) S[j] = 0.f;
  }
  bf16* SU = (bf16*)(p.ws + W_SU);
  const float* BL = (const float*)(p.ws + W_BL);
  const float* CM = (const float*)(p.ws + W_CM);
  for (int n0 = 0; n0 < NC; n0 += UN) {
    uint4 U[UN];
    float4 bl[UN][2], cmv[UN][2];
#pragma unroll
    for (int q = 0; q < UN; ++q) {
      int n = n0 + q, cid = dir == 0 ? cbase + n : cbase + NC - 1 - n;
      size_t idx = (size_t)(cid * 4 + h) * 2 + dir;
      U[q] = *(const uint4*)(SU + idx * 16384 + e * 128 + i0);
      bl[q][0] = *(const float4*)(BL + idx * 128 + i0); bl[q][1] = *(const float4*)(BL + idx * 128 + i0 + 4);
      cmv[q][0] = *(const float4*)(CM + idx * 128 + i0); cmv[q][1] = *(const float4*)(CM + idx * 128 + i0 + 4);
    }
#pragma unroll
    for (int q = 0; q < UN; ++q) {
      int n = n0 + q, cid = dir == 0 ? cbase + n : cbase + NC - 1 - n;
      size_t idx = (size_t)(cid * 4 + h) * 2 + dir;
      const float* blf = (const float*)&bl[q][0];
      const float* cmf = (const float*)&cmv[q][0];
      const unsigned* uu = (const unsigned*)&U[q];
      uint4 o;
      unsigned* op = (unsigned*)&o;
#pragma unroll
      for (int j = 0; j < 8; j += 2) op[j >> 1] = pack2(S[j] * __expf(cmf[j]), S[j + 1] * __expf(cmf[j + 1]));
      *(uint4*)(SU + idx * 16384 + e * 128 + i0) = o;
#pragma unroll
      for (int j = 0; j < 8; ++j) {
        float uv = bf2f((bf16)((uu[j >> 1] >> ((j & 1) * 16)) & 0xffff));
        S[j] = __expf(blf[j]) * S[j] + uv;
      }
    }
  }
  if (sout) {
#pragma unroll
    for (int j = 0; j < 8; ++j) tb_[(i0 + j) * 17 + (tid >> 4)] = S[j];
    __syncthreads();
    const float* d = tb_ + ti_ * 17 + th_;
    *(float4*)(sout + (size_t)ti_ * 128 + es * 16 + th_) = make_float4(d[0], d[1], d[2], d[3]);
    *(float4*)(sout + (size_t)ti_ * 128 + es * 16 + th_ + 4) = make_float4(d[4], d[5], d[6], d[7]);
  }
}

DEV void hgrn_c(const P& p, int l, int cid, int h, char* lds) {
  const int tid = ltid(), lane = tid & 63, w = tid >> 6, ll = lane & 31, hh = lane >> 5;
  const int d = tid & 127, hf = tid >> 7;
  const int tt = w & 1, eh = w >> 1;
  bf16* qd = (bf16*)lds;
  bf16* kd = (bf16*)(lds + 64 * 272);
  bf16* vT = (bf16*)(lds + 2 * 64 * 272);
  float* sTot = (float*)(lds + 2 * 64 * 272 + 128 * 144);
  float* red = sTot + 256;
  const bf16* Z = (const bf16*)(p.ws + W_Z);
  const int tl0 = cid * 64 + hf * 32;
  f32x16 o[2];
  zero16(o[0]); zero16(o[1]);
#pragma unroll 1
  for (int dir = 0; dir < 2; ++dir) {
    const int idx = (cid * 4 + h) * 2 + dir;
    const _Float16* LG = (const _Float16*)(p.ws + (dir ? W_LGB : W_LGF)) + (size_t)tl0 * 512 + h * 128 + d;
    __syncthreads();
    bf16x8 sfr[2][8];
    {
      const bf16* Sg = (const bf16*)(p.ws + W_SU) + (size_t)idx * 16384;
#pragma unroll
      for (int e2 = 0; e2 < 2; ++e2)
#pragma unroll
        for (int ks = 0; ks < 8; ++ks) sfr[e2][ks] = *(const bf16x8*)(Sg + ((eh * 2 + e2) * 32 + ll) * 128 + ks * 16 + hh * 8);
    }
    const float tot_ = ((const float*)(p.ws + W_BL))[(size_t)idx * 128 + d], cm = ((const float*)(p.ws + W_CM))[(size_t)idx * 128 + d];
    const float t0_ = dir == 0 ? cm : tot_ - cm, t1_ = dir == 0 ? tot_ - cm : cm;
    float bb = dir == 0 ? (hf == 1 ? t0_ : 0.f) : (hf == 0 ? t1_ : 0.f);
    {
      const bf16* qp = Z + (size_t)tl0 * ZS + C_AQ + h * 128 + d;
      const bf16* vp = Z + (size_t)tl0 * ZS + C_AI + h * 128 + d;
#pragma unroll
      for (int rr = 0; rr < 32; ++rr) {
        const int r = dir == 0 ? rr : 31 - rr;
        const float lg = LG[(size_t)r * 512];
        bb += lg;
        const float qv = bf2f(qp[(size_t)r * ZS]);
        qd[(hf * 32 + r) * 136 + d] = f2bf(qv * __expf(bb - cm));
        kd[(hf * 32 + r) * 136 + d] = f2bf(-expm1f(lg) * __expf(cm - bb));
        if (dir == 0) vT[d * 72 + hf * 32 + r] = vp[(size_t)r * ZS];
      }
    }
    __syncthreads();
    bf16x8 qf[8];
#pragma unroll
    for (int ks = 0; ks < 8; ++ks) qf[ks] = *(const bf16x8*)(qd + (tt * 32 + ll) * 136 + ks * 16 + hh * 8);
#pragma unroll
    for (int st = 0; st < 2; ++st) {
      const bool use = dir == 0 ? (st <= tt) : (st >= tt);
      if (!use) continue;
      f32x16 x;
      zero16(x);
#pragma unroll
      for (int ks = 0; ks < 8; ++ks) x = MFMA(*(const bf16x8*)(kd + (st * 32 + ll) * 136 + ks * 16 + hh * 8), qf[ks], x);
      if (st == tt) {
#pragma unroll
        for (int reg = 0; reg < 16; ++reg) {
          int sl = rowoff(reg, hh);
          bool keep = dir == 0 ? (sl <= ll) : (sl >= ll);
          x[reg] = keep ? x[reg] : 0.f;
        }
      }
#pragma unroll
      for (int s2 = 0; s2 < 2; ++s2) {
        bf16x8 pf = packf8n(x, s2);
#pragma unroll
        for (int e2 = 0; e2 < 2; ++e2) {
          const bf16* vp = vT + ((eh * 2 + e2) * 32 + ll) * 72 + st * 32 + 16 * s2 + 4 * hh;
          o[e2] = MFMA(comb(*(const uint2*)vp, *(const uint2*)(vp + 8)), pf, o[e2]);
        }
      }
    }
#pragma unroll
    for (int e2 = 0; e2 < 2; ++e2)
#pragma unroll
      for (int ks = 0; ks < 8; ++ks) o[e2] = MFMA(sfr[e2][ks], qf[ks], o[e2]);
  }
  float ss = 0.f;
#pragma unroll
  for (int e2 = 0; e2 < 2; ++e2)
#pragma unroll
    for (int i = 0; i < 16; ++i) ss += o[e2][i] * o[e2][i];
  ss += __shfl_xor(ss, 32);
  if (hh == 0) red[eh * 64 + tt * 32 + ll] = ss;
  __syncthreads();
  const float rstd = rsqrtf((red[tt * 32 + ll] + red[64 + tt * 32 + ll]) * (1.f / 128.f) + EPS);
  const int tl = cid * 64 + tt * 32 + ll;
  bf16* BR = (bf16*)(p.ws + W_BR);
#pragma unroll
  for (int e2 = 0; e2 < 2; ++e2)
#pragma unroll
    for (int g4 = 0; g4 < 4; ++g4) {
      int e = (eh * 2 + e2) * 32 + 8 * g4 + 4 * hh;
      float4 ng = *(const float4*)(p.hg_norm_g + l * 128 + e);
      uint2 gr = *(const uint2*)(Z + (size_t)tl * ZS + C_AG + h * 128 + e);
      uint2 ov;
      ov.x = pack2(o[e2][4 * g4] * rstd * ng.x * bf2f(gr.x & 0xffff), o[e2][4 * g4 + 1] * rstd * ng.y * bf2f(gr.x >> 16));
      ov.y = pack2(o[e2][4 * g4 + 2] * rstd * ng.z * bf2f(gr.y & 0xffff), o[e2][4 * g4 + 3] * rstd * ng.w * bf2f(gr.y >> 16));
      *(uint2*)(BR + (size_t)tl * 2048 + h * 128 + e) = ov;
    }
}

#define XB_TMO      128
#define XB_XCNT(j)  (256  + 64 * (j))
#define XB_XSUB(j)  (1280 + 64 * (j))
#define XB_XGEN(j)  (2304 + 64 * (j))
#define XB_TOP      3328
#define XB_TOPGEN   3392
#define XCD_BAR_WORDS 3456
#define XB_SPIN_CAP (1u << 18)
#define LAS __attribute__((address_space(3)))

__device__ __forceinline__ unsigned xb_ld(unsigned* p)              { return __hip_atomic_load(p, __ATOMIC_RELAXED, __HIP_MEMORY_SCOPE_AGENT); }
__device__ __forceinline__ unsigned xb_add(unsigned* p, unsigned v) { return __hip_atomic_fetch_add(p, v, __ATOMIC_RELAXED, __HIP_MEMORY_SCOPE_AGENT); }
__device__ __forceinline__ unsigned xb_xcc_id() { return (unsigned)__builtin_amdgcn_s_getreg((3 << 11) | 20) & 0xFu; }
#define XB_SPIN(cond, bar) do { unsigned _sp = 0; while (cond) { __builtin_amdgcn_s_sleep(1); \
    if ((++_sp & 255u) == 0u) { if (xb_ld(&(bar)[XB_TMO])) break; if (_sp > XB_SPIN_CAP) { atomicAdd(&(bar)[XB_TMO], 1u); break; } } } } while (0)

struct XcdBarrier {
    unsigned* bar; unsigned x;
    volatile LAS unsigned* st;
};

__device__ __forceinline__ XcdBarrier xcd_barrier_post(unsigned* bar, volatile LAS unsigned* st) {
    XcdBarrier b; b.bar = bar; b.x = xb_xcc_id(); b.st = st;
    if (threadIdx.x == 0) (void)xb_add(&bar[XB_XCNT(b.x)], 1u);
    return b;
}
__device__ __forceinline__ void xcd_barrier_complete(unsigned* bar, unsigned x, unsigned& nloc, unsigned& nx) {
    const unsigned G = gridDim.x * gridDim.y * gridDim.z;
    unsigned sum, cnt, mine, sp = 0u;
    for (;;) {
        sum = 0u; cnt = 0u; mine = 0u;
#pragma unroll
        for (unsigned j = 0; j < 16; ++j) { const unsigned c = xb_ld(&bar[XB_XCNT(j)]); sum += c; cnt += (c > 0u) ? 1u : 0u; mine = (j == x) ? c : mine; }
        if (sum == G) break;
        __builtin_amdgcn_s_sleep(1);
        if ((++sp & 255u) == 0u) { if (xb_ld(&bar[XB_TMO])) break; if (sp > XB_SPIN_CAP) { atomicAdd(&bar[XB_TMO], 1u); break; } }
    }
    nloc = mine > 0u ? mine : 1u; nx = cnt > 0u ? cnt : 1u;
}

__device__ __forceinline__ void xcd_barrier(const XcdBarrier& b) {
    asm volatile("s_waitcnt vmcnt(0)" ::: "memory");
    __syncthreads();
    if (threadIdx.x == 0) {
        unsigned* bar = b.bar;
        __builtin_amdgcn_s_waitcnt(0);
        unsigned nloc = b.st[0], nx = b.st[1];
        if (nloc == 0u) { xcd_barrier_complete(bar, b.x, nloc, nx); b.st[0] = nloc; b.st[1] = nx; }
        const unsigned old = xb_add(&bar[XB_XSUB(b.x)], 1u);
        const unsigned gen = old / nloc;
        if (old + 1u == (gen + 1u) * nloc) {
            __builtin_amdgcn_fence(__ATOMIC_RELEASE, "agent");
            asm volatile("s_waitcnt vmcnt(0)" ::: "memory");
            const unsigned og = xb_add(&bar[XB_TOP], 1u);
            const unsigned tg = og / nx;
            if (og + 1u == (tg + 1u) * nx) xb_add(&bar[XB_TOPGEN], 1u);
            else XB_SPIN(xb_ld(&bar[XB_TOPGEN]) == tg, bar);
            __builtin_amdgcn_fence(__ATOMIC_ACQUIRE, "agent");
            xb_add(&bar[XB_XGEN(b.x)], 1u);
            asm volatile("s_waitcnt vmcnt(0)" ::: "memory");
        } else {
            XB_SPIN(xb_ld(&bar[XB_XGEN(b.x)]) == gen, bar);
            __builtin_amdgcn_fence(__ATOMIC_ACQUIRE, "agent");
            asm volatile("s_waitcnt vmcnt(0)" ::: "memory");
        }
    }
    __syncthreads();
}


DEV int next_job(unsigned* ctr, int* sjob) {
  __syncthreads();
  if (threadIdx.x == 0) *sjob = (int)atomicAdd(ctr, 1u);
  __syncthreads();
  return *sjob;
}

__global__ void __launch_bounds__(256, 2) mega(P p) {
  extern __shared__ __attribute__((aligned(16))) char lds[];
  cg::grid_group grid = cg::this_grid();
  const int nb = gridDim.x, bid = blockIdx.x;
  __shared__ uint4 xb_words;
  int* sjob = (int*)&xb_words + 2;
  unsigned* qctr = (unsigned*)(p.ws + W_CTR) + 3584;
  if (threadIdx.x == 0) xb_words = make_uint4(0u, 0u, 0u, 0u);
  __syncthreads();
  XcdBarrier xb = xcd_barrier_post((unsigned*)(p.ws + W_CTR), (volatile LAS unsigned*)&xb_words);

  {
    const int J0 = 2 * 16 * 183, J1 = J0 + 8 * 8 * 16, J2 = J1 + 2 * 16 * 16, J3 = J2 + 2 * 4 * 12, J4 = J3 + 2 * 2 * 16,
              J5 = J4 + 96, J6 = J5 + 128;
    for (int job = bid; job < J6; job += nb) {
      if (job < J0) {
        int l = job / (16 * 183), r = job % (16 * 183);
        tr_tile(p.w_in + (size_t)l * 1024 * ZW, (bf16*)(p.ws + W_WIN) + (size_t)l * ZW * 1024, 1024, ZW, r & 15, r >> 4, lds);
      } else if (job < J1) {
        int j = job - J0, mtx = j >> 7, r = j & 127;
        tr_tile(p.w_branch + (size_t)mtx * 512 * 1024, (bf16*)(p.ws + W_WBR) + (size_t)(mtx >> 2) * 1024 * 2048 + (mtx & 3) * 512, 512, 1024, r & 7, r >> 3, lds, 2048);
      } else if (job < J2) {
        int j = job - J1, l = j >> 8, r = j & 255;
        tr_tile(p.w_out + (size_t)l * 1024 * 1024, (bf16*)(p.ws + W_WOUT) + (size_t)l * 1024 * 1024, 1024, 1024, r & 15, r >> 4, lds);
      } else if (job < J3) {
        int j = job - J2, l = j / 48, r = j % 48;
        tr_tile(p.w_qb + (size_t)l * 256 * 768, (bf16*)(p.ws + W_WQB) + (size_t)l * 768 * 256, 256, 768, r & 3, r >> 2, lds);
      } else if (job < J4) {
        int j = job - J3, l = j >> 5, r = j & 31;
        tr_tile(p.w_kvb + (size_t)l * 128 * 1024, (bf16*)(p.ws + W_WKVB) + (size_t)l * 1024 * 128, 128, 1024, r & 1, r >> 1, lds);
      } else if (job < J5) {
        int j = job - J4;
        mod_job(p, j / 48, j % 48, lds);
      } else {
        cache_job(p, job - J5, lds);
      }
    }
  }
  grid.sync();

  for (int grp = 0; grp < 9 / GU; ++grp) {
    const int u0 = grp * GU, nu = GU, g0 = u0 * UT;
    const int nlat = (grp == 0) ? nu - 1 : nu;
    const int ulat0 = (grp == 0) ? 1 : 0;
    const int MT = nu * 32;
    for (int job = bid; job < nu * 256; job += nb) h_job(p, 0, g0, job);
    xcd_barrier(xb);
    for (int l = 0; l < 2; ++l) {
      {
        const int mpx = MT >> 3, xq = bid & 7, local = bid >> 3, npl = (nb >> 3) / mpx;
        if (local < npl * mpx)
          for (int nt = local / mpx; nt < 60; nt += npl) gemm1_job(p, l, g0, xq * mpx + local % mpx, nt * 128, C_MG, lds);
      }
      xcd_barrier(xb);
      {
        const int J1 = nu * 512, J2 = J1 + nu * 128, J3 = J2 + nlat * 8, J4 = J3 + nu * 128;
        unsigned* ctr = qctr++;
        for (int job = next_job(ctr, sjob); job < J4; job = next_job(ctr, sjob)) {
          if (job < J1) {
            hgrn_a(p, job >> 3, (job >> 1) & 3, job & 1, lds);
          } else if (job < J2) {
            mlaprep_job(p, l, g0, job - J1);
          } else if (job < J3) {
            int j = job - J2;
            mlatail_job(p, l, g0, ulat0 + (j >> 3), j & 7);
          } else {
            conv_job(p, l, g0, job - J3);
          }
        }
      }
      xcd_barrier(xb);
      {
        const int nctx = nu - nlat;
        const int J0 = nlat * 64, J1 = J0 + nctx * 1024, J2 = J1 + MT * 6, J3 = J2 + nu * 34 * 8;
        unsigned* ctr = qctr++;
        for (int job = next_job(ctr, sjob); job < J3; job = next_job(ctr, sjob)) {
          if (job < J0) {
            int ug = ulat0 + (job >> 6), r = job & 63, es = r & 7, ch = r >> 3, h = ch >> 1, dir = ch & 1;
            int b = ((g0 >> 12) + ug) - 1;
            hgrn_b<8>(p, l, ug * 64, 64, h, dir, es, p.state_hgrn + ((size_t)((b * 2 + l) * 2 + dir) * 4 + h) * 16384, nullptr, lds);
          } else if (job < J1) {
            int j = job - J0, es = j & 7, ch = j >> 3, dir = ch & 1, h = (ch >> 1) & 3, seq = ch >> 3;
            hgrn_b<4>(p, l, seq * 4, 4, h, dir, es, nullptr, p.out + O_ST + ((size_t)((seq * 2 + l) * 2 + dir) * 4 + h) * 16384, lds);
          } else if (job < J2) {
            int j = job - J1;
            gemmq_job(p, l, g0, j / 6, j % 6, lds);
          } else {
            int j = job - J2, ug = j / 272, r = j % 272, mt = r >> 3, nt = r & 7;
            bool isctx = (g0 + ug * UT) < UT;
            if (isctx && mt >= 32) continue;
            gemmkv_job(p, l, ug, mt, nt, lds);
          }
        }
      }
      xcd_barrier(xb);
      {
        {
          const int xq = bid & 7, local = bid >> 3, npairs = nu * 4;
          if (npairs == 12 && (nb >> 3) >= 48) {
            if (local < 32) mla_job(p, g0, xq >> 2, local, xq & 3, lds);
            else if (local < 48) { const int pp = 8 + (xq >> 1); mla_job(p, g0, pp >> 2, (xq & 1) * 16 + (local - 32), pp & 3, lds); }
          } else {
            const int npx = (npairs - xq + 7) >> 3;
            for (int jj = local; jj < 32 * npx; jj += (nb >> 3)) {
              const int pp = xq + 8 * (jj >> 5);
              mla_job(p, g0, pp >> 2, jj & 31, pp & 3, lds);
            }
          }
        }
        const int J1 = nu * 256, J2 = J1 + nu * 256;
        unsigned* ctr = qctr++;
        for (int job = next_job(ctr, sjob); job < J2; job = next_job(ctr, sjob)) {
          if (job < J1) {
            int ug = job >> 8, r = job & 255;
            na_wave(p, l, g0, ug, r >> 1, (r & 1) * 4 + (ltid() >> 6), lds);
          } else {
            int j = job - J1;
            hgrn_c(p, l, j >> 2, j & 3, lds);
          }
        }
      }
      xcd_barrier(xb);
      {
        const int xq = bid & 7, local = bid >> 3, hm = MT >> 1;
        for (int j = local; j < 2 * hm; j += (nb >> 3)) gemm3_job(p, l, (xq >> 2) * hm + (j >> 1), 2 * (xq & 3) + (j & 1), lds);
      }
      xcd_barrier(xb);
      {
        const int xq = bid & 7, local = bid >> 3, hm = MT >> 1;
        for (int j = local; j < 2 * hm; j += (nb >> 3)) gemm4_job(p, l, g0, (xq >> 2) * hm + (j >> 1), 2 * (xq & 3) + (j & 1), lds);
      }
      xcd_barrier(xb);
      for (int job = bid; job < nu * 256; job += nb) ln_job(p, l, g0, job);
      xcd_barrier(xb);
    }
  }
}

extern "C" void kernel_launch(void* const* d_in, const int* in_sizes, int n_in, void* d_out, int out_size, void* d_ws,
                              size_t ws_size, hipStream_t stream) {
  static int grid_blocks = 0;
  if (!grid_blocks) {
    int dev = 0, cus = 0, per_cu = 0;
    hipGetDevice(&dev);
    hipDeviceGetAttribute(&cus, hipDeviceAttributeMultiprocessorCount, dev);
    hipFuncSetAttribute((const void*)mega, hipFuncAttributeMaxDynamicSharedMemorySize, LDS_BYTES);
    hipOccupancyMaxActiveBlocksPerMultiprocessor(&per_cu, mega, 256, LDS_BYTES);
    if (per_cu > 2) per_cu = 2;
    if (per_cu < 1) per_cu = 1;
    grid_blocks = cus * per_cu;
  }
  if (ws_size < W_END) fprintf(stderr, "workspace too small: %zu < %zu\n", ws_size, (size_t)W_END);
  P p{};
  const float** pp = (const float**)&p;
  for (int i = 0; i < 25; ++i) pp[i] = (const float*)d_in[i];
  p.out = (float*)d_out;
  p.ws = (char*)d_ws;
  void* args[] = {&p};
  (void)hipMemsetAsync((char*)d_ws + W_CTR, 0, 16384, stream);
  hipError_t e = hipLaunchCooperativeKernel((const void*)mega, dim3(grid_blocks), dim3(256), args, LDS_BYTES, stream);
  if (e != hipSuccess) fprintf(stderr, "cooperative launch failed: %s (grid %d)\n", hipGetErrorString(e), grid_blocks);
}
```

```cpp
#include <hip/hip_runtime.h>
#include <hip/hip_cooperative_groups.h>
#include <cstdio>
namespace cg = cooperative_groups;

typedef unsigned short bf16;
typedef __attribute__((ext_vector_type(8))) short bf16x8;
typedef __attribute__((ext_vector_type(16))) float f32x16;
#define DEV __device__ __forceinline__
#define MFMA(a, b, c) __builtin_amdgcn_mfma_f32_32x32x16_bf16((a), (b), (c), 0, 0, 0)

constexpr int ZW = 11712, ZS = 7616, GU = 3, GT = GU * 4096, UT = 4096, KVR = 4352;
constexpr float LOG2E = 1.4426950408889634f;
constexpr float QS_NA = 0.125f * LOG2E;
constexpr float QS_MLA = 0.07216878364870322f * LOG2E;
constexpr float EPS = 1e-6f;
constexpr float ALPHA = 1.4142135623730951f;
constexpr int C_AQ = 0, C_AFF = 512, C_AFB = 1024, C_AI = 1536, C_AG = 2048, C_BQ = 2560, C_BK = 3072,
              C_BV = 3584, C_BG = 4096, C_QD = 4608, C_KVD = 4864, C_KPE = 4992, C_CG = 5056, C_DB = 5568,
              C_DC = 6080, C_DX = 6592, C_DG = 7104, C_MG = 7616;
constexpr size_t O_ST = 37748736, O_NK = 41943040, O_NV = 46137344, O_CKV = 50331648, O_KPE = 51380224;

constexpr size_t al(size_t x) { return (x + 255) & ~(size_t)255; }
constexpr size_t W_CTR = 0;
constexpr size_t W_WIN = 16384;
constexpr size_t W_WBR = W_WIN + al((size_t)2 * ZW * 1024 * 2);
constexpr size_t W_WOUT = W_WBR + al((size_t)2 * 4 * 1024 * 512 * 2);
constexpr size_t W_WQB = W_WOUT + al((size_t)2 * 1024 * 1024 * 2);
constexpr size_t W_WKVB = W_WQB + al((size_t)2 * 768 * 256 * 2);
constexpr size_t W_MOD = W_WKVB + al((size_t)2 * 1024 * 128 * 2);
constexpr size_t W_CK = W_MOD + al((size_t)2 * 9 * 3072 * 4);
constexpr size_t W_CVT = W_CK + al((size_t)8 * 2 * 8 * 256 * 64 * 2);
constexpr size_t W_H = W_CVT + al((size_t)8 * 2 * 8 * 256 * 64 * 2);
constexpr size_t W_Z = W_H + al((size_t)GT * 1024 * 2);
constexpr size_t W_LGF = W_Z + al((size_t)GT * ZS * 2);
constexpr size_t W_LGB = W_LGF + (size_t)GT * 512 * 4;
constexpr size_t W_SU = W_LGB + (size_t)GT * 512 * 4;
constexpr size_t W_G = W_LGF;
constexpr size_t W_KVPE = W_SU + al((size_t)(GT / 64) * 8 * 16384 * 2);
constexpr size_t W_NVT = W_KVPE + al((size_t)GT * 192 * 4);
constexpr size_t W_QN = W_NVT + al((size_t)512 * GT * 2);
constexpr size_t W_QM = W_QN + (size_t)GT * 256 * 2;
constexpr size_t W_MB = W_QN;
constexpr size_t W_CKVB = W_QM + al((size_t)GT * 768 * 2);
constexpr size_t W_KPER = W_CKVB + al((size_t)GU * KVR * 128 * 2);
constexpr size_t W_KN = W_KPER + al((size_t)GU * KVR * 64 * 2);
constexpr size_t W_VT = W_KN + al((size_t)GU * KVR * 512 * 2);
constexpr size_t W_BL = W_VT + al((size_t)GU * 512 * KVR * 2);
constexpr size_t W_CM = W_BL + al((size_t)(GT / 64) * 8 * 128 * 4);
constexpr size_t W_BR = W_CM + al((size_t)(GT / 64) * 8 * 128 * 4);
constexpr size_t W_END = W_BR + al((size_t)GT * 2048 * 2);
static_assert(W_END <= (size_t)512 * 1024 * 1024, "workspace layout exceeds 512 MiB");

constexpr int LDS_BYTES = 73728;
#ifndef DUP
#define DUP 0
#endif

struct P {
  const float *x_prompt, *x_sample, *state_hgrn, *cache_na_k, *cache_na_v, *cache_ckv, *cache_kpe, *c, *c_ctx,
      *w_ada, *b_ada, *w_in, *b_in, *lb_logits, *hg_norm_g, *na_rpb, *qnorm_g, *w_qb, *kvnorm_g, *w_kvb,
      *conv_w, *w_branch, *w_out, *ln_g, *ln_b;
  float* out;
  char* ws;
};

DEV bf16 f2bf(float f) { unsigned u = __float_as_uint(f); u += 0x7fffu + ((u >> 16) & 1u); return (bf16)(u >> 16); }
DEV float bf2f(bf16 b) { return __uint_as_float(((unsigned)b) << 16); }
DEV unsigned pack2(float a, float b) { unsigned r; asm("v_cvt_pk_bf16_f32 %0, %1, %2" : "=v"(r) : "v"(a), "v"(b)); return r; }
DEV float silu(float x) { return x * __builtin_amdgcn_rcpf(1.f + __expf(-x)); }
DEV float sigm(float x) { return __builtin_amdgcn_rcpf(1.f + __expf(-x)); }
DEV float ex2(float x) { return __builtin_amdgcn_exp2f(x); }
DEV int ltid() { int t = threadIdx.x; asm volatile("" : "+v"(t)); return t; }
typedef unsigned u32x2 __attribute__((ext_vector_type(2)));
DEV u32x2 lds_rd64(unsigned addr) { u32x2 v; asm volatile("ds_read_b64 %0, %1" : "=v"(v) : "v"(addr)); return v; }
DEV unsigned lds_addr(const void* p) { return (unsigned)(size_t)(__attribute__((address_space(3))) const char*)p; }
DEV bf16x8 comb2(u32x2 a, u32x2 b) { uint4 u = make_uint4(a.x, a.y, b.x, b.y); return *(bf16x8*)&u; }
DEV float xhalf_max(float x) {
  auto r = __builtin_amdgcn_permlane32_swap(__float_as_uint(x), __float_as_uint(x), false, false);
  return fmaxf(__uint_as_float(r[0]), __uint_as_float(r[1]));
}
DEV int rowoff(int reg, int hh) { return (reg & 3) + 8 * (reg >> 2) + 4 * hh; }
DEV bf16x8 packf8(const f32x16& x, int s) {
  uint4 u;
  u.x = pack2(x[8 * s + 0], x[8 * s + 1]); u.y = pack2(x[8 * s + 2], x[8 * s + 3]);
  u.z = pack2(x[8 * s + 4], x[8 * s + 5]); u.w = pack2(x[8 * s + 6], x[8 * s + 7]);
  return *(bf16x8*)&u;
}
typedef __bf16 nbf16x2 __attribute__((ext_vector_type(2)));
typedef float nf32x2 __attribute__((ext_vector_type(2)));
DEV unsigned pack2n(float a, float b) { nf32x2 v = {a, b}; nbf16x2 h = __builtin_convertvector(v, nbf16x2); return *(unsigned*)&h; }
DEV bf16x8 packf8n(const f32x16& x, int s) {
  uint4 u;
  u.x = pack2n(x[8 * s + 0], x[8 * s + 1]); u.y = pack2n(x[8 * s + 2], x[8 * s + 3]);
  u.z = pack2n(x[8 * s + 4], x[8 * s + 5]); u.w = pack2n(x[8 * s + 6], x[8 * s + 7]);
  return *(bf16x8*)&u;
}
DEV bf16x8 comb(uint2 a, uint2 b) { uint4 u = make_uint4(a.x, a.y, b.x, b.y); return *(bf16x8*)&u; }
DEV const float* xin_row(const P& p, int g) {
  return g < UT ? p.x_prompt + (size_t)g * 1024 : p.x_sample + (size_t)(g - UT) * 1024;
}
DEV void zero16(f32x16& a) {
#pragma unroll
  for (int i = 0; i < 16; ++i) a[i] = 0.f;
}

struct NoHook { DEV void operator()(int) const {} };
template <int BN, typename HOOK = NoHook>
DEV void gemm_core(f32x16 (&acc)[2][BN / 64], const bf16* __restrict__ A, int lda, const bf16* __restrict__ Bt,
                   int ldb, int nvalid, int K, char* lds, HOOK hook = NoHook()) {
  constexpr int NB = BN / 32;
  constexpr int WN = BN / 2;
  constexpr int STAGE = (128 + BN) * 128;
  const int tid = ltid(), lane = tid & 63, w = tid >> 6, wm = w >> 1, wn = w & 1, ll = lane & 31, hh = lane >> 5;
  const int lrow = tid >> 3, lch = (tid & 7) ^ ((tid >> 4) & 7);
  const bf16* abase = A + (size_t)lrow * lda + lch * 8;
  const bf16* bptr[NB];
#pragma unroll
  for (int i = 0; i < NB; ++i) { int r = lrow + 32 * i; r = r < nvalid ? r : nvalid - 1; bptr[i] = Bt + (size_t)r * ldb + lch * 8; }
  char* ldst = lds + tid * 16;
  const int key = (ll >> 1) & 7;
  int koff[4];
#pragma unroll
  for (int ks = 0; ks < 4; ++ks) koff[ks] = ((2 * ks + hh) ^ key) * 16;
  __syncthreads();
#pragma unroll
  for (int i = 0; i < 4; ++i)
    __builtin_amdgcn_global_load_lds((const unsigned*)(abase + (size_t)(32 * i) * lda), (__attribute__((address_space(3))) unsigned*)(ldst + i * 4096), 16, 0, 0);
#pragma unroll
  for (int i = 0; i < NB; ++i)
    __builtin_amdgcn_global_load_lds((const unsigned*)(bptr[i]), (__attribute__((address_space(3))) unsigned*)(ldst + 16384 + i * 4096), 16, 0, 0);
  asm volatile("s_waitcnt vmcnt(0)" ::: "memory");
  __syncthreads();
  const int nk = K >> 6;
  for (int kt = 0; kt < nk; ++kt) {
    if (kt + 1 < nk) {
      char* d = ldst + ((kt + 1) & 1) * STAGE;
#pragma unroll
      for (int i = 0; i < 4; ++i)
        __builtin_amdgcn_global_load_lds((const unsigned*)(abase + (size_t)(32 * i) * lda + (kt + 1) * 64), (__attribute__((address_space(3))) unsigned*)(d + i * 4096), 16, 0, 0);
#pragma unroll
      for (int i = 0; i < NB; ++i)
        __builtin_amdgcn_global_load_lds((const unsigned*)(bptr[i] + (kt + 1) * 64), (__attribute__((address_space(3))) unsigned*)(d + 16384 + i * 4096), 16, 0, 0);
    }
    const char* s = lds + (kt & 1) * STAGE;
    const char* sa = s + (wm * 64 + ll) * 128;
    const char* sb = s + 16384 + (wn * WN + ll) * 128;
#pragma unroll
    for (int ks = 0; ks < 4; ++ks) {
      bf16x8 a0 = *(const bf16x8*)(sa + koff[ks]), a1 = *(const bf16x8*)(sa + 32 * 128 + koff[ks]);
#pragma unroll
      for (int ni = 0; ni < BN / 64; ++ni) {
        bf16x8 b = *(const bf16x8*)(sb + ni * 32 * 128 + koff[ks]);
        acc[0][ni] = MFMA(a0, b, acc[0][ni]);
        acc[1][ni] = MFMA(a1, b, acc[1][ni]);
      }
    }
    __builtin_amdgcn_sched_group_barrier(0x100, 8, 0);
    __builtin_amdgcn_sched_group_barrier(0x008, 4, 0);
    __builtin_amdgcn_sched_group_barrier(0x100, 4, 0);
    __builtin_amdgcn_sched_group_barrier(0x008, 4, 0);
    __builtin_amdgcn_sched_group_barrier(0x100, 4, 0);
    __builtin_amdgcn_sched_group_barrier(0x008, 8, 0);
    hook(kt);
    asm volatile("s_waitcnt vmcnt(0)" ::: "memory");
    __syncthreads();
  }
}

DEV void tr_tile(const float* __restrict__ src, bf16* __restrict__ dst, int K, int N, int kt, int nt, char* lds, int dstK = 0) {
  if (dstK == 0) dstK = K;
  float* t = (float*)lds;
  const int tid = ltid();
  __syncthreads();
#pragma unroll
  for (int i = 0; i < 4; ++i) {
    int k = (tid >> 4) + 16 * i, n4 = (tid & 15) * 4;
    float4 v = *(const float4*)(src + (size_t)(kt * 64 + k) * N + nt * 64 + n4);
    t[k * 65 + n4] = v.x; t[k * 65 + n4 + 1] = v.y; t[k * 65 + n4 + 2] = v.z; t[k * 65 + n4 + 3] = v.w;
  }
  __syncthreads();
  const int n = tid >> 2, k0 = (tid & 3) * 16;
  uint4 o0, o1;
  o0.x = pack2(t[(k0 + 0) * 65 + n], t[(k0 + 1) * 65 + n]); o0.y = pack2(t[(k0 + 2) * 65 + n], t[(k0 + 3) * 65 + n]);
  o0.z = pack2(t[(k0 + 4) * 65 + n], t[(k0 + 5) * 65 + n]); o0.w = pack2(t[(k0 + 6) * 65 + n], t[(k0 + 7) * 65 + n]);
  o1.x = pack2(t[(k0 + 8) * 65 + n], t[(k0 + 9) * 65 + n]); o1.y = pack2(t[(k0 + 10) * 65 + n], t[(k0 + 11) * 65 + n]);
  o1.z = pack2(t[(k0 + 12) * 65 + n], t[(k0 + 13) * 65 + n]); o1.w = pack2(t[(k0 + 14) * 65 + n], t[(k0 + 15) * 65 + n]);
  bf16* d = dst + (size_t)(nt * 64 + n) * dstK + kt * 64 + k0;
  *(uint4*)d = o0; *(uint4*)(d + 8) = o1;
}

DEV void mod_job(const P& p, int l, int cb, char* lds) {
  float* sc = (float*)lds;
  float* red = sc + 9 * 1024;
  const int tid = ltid();
  __syncthreads();
  for (int i = tid; i < 9 * 1024; i += 256) {
    int c = i >> 10, k = i & 1023;
    float v = c == 0 ? p.c_ctx[k] : p.c[(c - 1) * 1024 + k];
    sc[i] = silu(v);
  }
  __syncthreads();
  const int col = cb * 64 + (tid & 63), kq = tid >> 6;
  float a[9];
#pragma unroll
  for (int c = 0; c < 9; ++c) a[c] = 0.f;
  const float* wp = p.w_ada + ((size_t)l * 1024 + kq * 256) * 3072 + col;
#pragma unroll 8
  for (int k = 0; k < 256; ++k) {
    float wv = wp[(size_t)k * 3072];
#pragma unroll
    for (int c = 0; c < 9; ++c) a[c] += sc[c * 1024 + kq * 256 + k] * wv;
  }
#pragma unroll
  for (int c = 0; c < 9; ++c) red[(kq * 9 + c) * 64 + (tid & 63)] = a[c];
  __syncthreads();
  float* mod = (float*)(p.ws + W_MOD);
  for (int i = tid; i < 9 * 64; i += 256) {
    int c = i >> 6, j = i & 63;
    float s = red[(0 * 9 + c) * 64 + j] + red[(1 * 9 + c) * 64 + j] + red[(2 * 9 + c) * 64 + j] + red[(3 * 9 + c) * 64 + j];
    mod[(size_t)(l * 9 + c) * 3072 + cb * 64 + j] = s + p.b_ada[l * 3072 + cb * 64 + j];
  }
}

DEV void cache_job(const P& p, int job, char* lds) {
  const int tid = ltid();
  const int bl = job >> 3, h = job & 7;
  bf16* CK = (bf16*)(p.ws + W_CK) + (size_t)job * 256 * 64;
  bf16* CV = (bf16*)(p.ws + W_CVT) + (size_t)job * 64 * 256;
  const float* ks = p.cache_na_k + (size_t)bl * 256 * 512 + h * 64;
  const float* vs = p.cache_na_v + (size_t)bl * 256 * 512 + h * 64;
  float* t = (float*)lds;
  __syncthreads();
  for (int i = tid; i < 256 * 16; i += 256) {
    int r = i >> 4, c4 = (i & 15) * 4;
    float4 kv = *(const float4*)(ks + (size_t)r * 512 + c4);
    uint2 o; o.x = pack2(kv.x, kv.y); o.y = pack2(kv.z, kv.w);
    *(uint2*)(CK + r * 64 + c4) = o;
    float4 vv = *(const float4*)(vs + (size_t)r * 512 + c4);
    t[r * 65 + c4] = vv.x; t[r * 65 + c4 + 1] = vv.y; t[r * 65 + c4 + 2] = vv.z; t[r * 65 + c4 + 3] = vv.w;
  }
  __syncthreads();
  for (int i = tid; i < 64 * 64; i += 256) {
    int e = i >> 6, t4 = (i & 63) * 4;
    uint2 o; o.x = pack2(t[(t4)*65 + e], t[(t4 + 1) * 65 + e]); o.y = pack2(t[(t4 + 2) * 65 + e], t[(t4 + 3) * 65 + e]);
    *(uint2*)(CV + e * 256 + t4) = o;
  }
}

DEV void h_job(const P& p, int l, int g0, int tb) {
  const int tid_ = ltid(); const int lane = tid_ & 63, w = tid_ >> 6;
  bf16* H = (bf16*)(p.ws + W_H);
  const float* mod = (const float*)(p.ws + W_MOD);
#pragma unroll
  for (int i = 0; i < 4; ++i) {
    int tl = tb * 16 + w * 4 + i, g = g0 + tl, cond = g >> 12;
    const float* x = xin_row(p, g);
    const float* md = mod + (size_t)(l * 9 + cond) * 3072;
#pragma unroll
    for (int j = 0; j < 4; ++j) {
      int col = lane * 4 + 256 * j;
      float4 xv = *(const float4*)(x + col), sh = *(const float4*)(md + col), sc = *(const float4*)(md + 1024 + col);
      uint2 o; o.x = pack2(xv.x * (1.f + sc.x) + sh.x, xv.y * (1.f + sc.y) + sh.y);
      o.y = pack2(xv.z * (1.f + sc.z) + sh.z, xv.w * (1.f + sc.w) + sh.w);
      *(uint2*)(H + (size_t)tl * 1024 + col) = o;
    }
  }
}

DEV void ln_job(const P& p, int l, int g0, int tb) {
  const int tid_ = ltid(); const int lane = tid_ & 63, w = tid_ >> 6;
  bf16* H = (bf16*)(p.ws + W_H);
  const float* mod = (const float*)(p.ws + W_MOD);
#pragma unroll
  for (int i = 0; i < 4; ++i) {
    int tl = tb * 16 + w * 4 + i, g = g0 + tl, cond = g >> 12;
    float* y = p.out + (size_t)g * 1024;
    float4 v[4];
    float s = 0.f;
#pragma unroll
    for (int j = 0; j < 4; ++j) { v[j] = *(const float4*)(y + lane * 4 + 256 * j); s += v[j].x + v[j].y + v[j].z + v[j].w; }
#pragma unroll
    for (int o = 32; o > 0; o >>= 1) s += __shfl_xor(s, o);
    float mu = s * (1.f / 1024.f), q = 0.f;
#pragma unroll
    for (int j = 0; j < 4; ++j) {
      v[j].x -= mu; v[j].y -= mu; v[j].z -= mu; v[j].w -= mu;
      q += v[j].x * v[j].x + v[j].y * v[j].y + v[j].z * v[j].z + v[j].w * v[j].w;
    }
#pragma unroll
    for (int o = 32; o > 0; o >>= 1) q += __shfl_xor(q, o);
    float rs = rsqrtf(q * (1.f / 1024.f) + EPS);
    const float* md = mod + (size_t)((l + 1) * 9 + cond) * 3072;
#pragma unroll
    for (int j = 0; j < 4; ++j) {
      int col = lane * 4 + 256 * j;
      float4 gg = *(const float4*)(p.ln_g + l * 1024 + col), bb = *(const float4*)(p.ln_b + l * 1024 + col);
      float4 o;
      o.x = v[j].x * rs * gg.x + bb.x; o.y = v[j].y * rs * gg.y + bb.y;
      o.z = v[j].z * rs * gg.z + bb.z; o.w = v[j].w * rs * gg.w + bb.w;
      *(float4*)(y + col) = o;
      if (l == 0) {
        float4 sh = *(const float4*)(md + col), sc = *(const float4*)(md + 1024 + col);
        uint2 hb; hb.x = pack2(o.x * (1.f + sc.x) + sh.x, o.y * (1.f + sc.y) + sh.y);
        hb.y = pack2(o.z * (1.f + sc.z) + sh.z, o.w * (1.f + sc.w) + sh.w);
        *(uint2*)(H + (size_t)tl * 1024 + col) = hb;
      }
    }
  }
}

DEV float rope_inv(int i) { return ex2(-(float)(i & 15) * (13.287712379549449f / 16.f)); }

DEV void mlaprep_job(const P& p, int l, int g0, int tb) {
  const int tid_ = ltid(); const int lane = tid_ & 63, w = tid_ >> 6;
  const bf16* Z = (const bf16*)(p.ws + W_Z);
  const float* KVPE = (const float*)(p.ws + W_KVPE);
  bf16* QN = (bf16*)(p.ws + W_QN);
  bf16* CKVB = (bf16*)(p.ws + W_CKVB);
  bf16* KPER = (bf16*)(p.ws + W_KPER);
  for (int i = 0; i < 8; ++i) {
    int tl = tb * 32 + w * 8 + i, g = g0 + tl, ug = tl >> 12, tu = tl & 4095;
    bool isctx = g < UT;
    uint2 qr = *(const uint2*)(Z + (size_t)tl * ZS + C_QD + lane * 4);
    float q0 = bf2f(qr.x & 0xffff), q1 = bf2f(qr.x >> 16), q2 = bf2f(qr.y & 0xffff), q3 = bf2f(qr.y >> 16);
    float ss = q0 * q0 + q1 * q1 + q2 * q2 + q3 * q3;
#pragma unroll
    for (int o = 32; o > 0; o >>= 1) ss += __shfl_xor(ss, o);
    float r = rsqrtf(ss * (1.f / 256.f) + EPS);
    float4 gq = *(const float4*)(p.qnorm_g + l * 256 + lane * 4);
    uint2 qo; qo.x = pack2(q0 * r * gq.x, q1 * r * gq.y); qo.y = pack2(q2 * r * gq.z, q3 * r * gq.w);
    *(uint2*)(QN + (size_t)tl * 256 + lane * 4) = qo;
    float2 kv = *(const float2*)(KVPE + (size_t)tl * 192 + lane * 2);
    float s2 = kv.x * kv.x + kv.y * kv.y;
#pragma unroll
    for (int o = 32; o > 0; o >>= 1) s2 += __shfl_xor(s2, o);
    float r2 = rsqrtf(s2 * (1.f / 128.f) + EPS);
    float2 gk = *(const float2*)(p.kvnorm_g + l * 128 + lane * 2);
    float c0 = kv.x * r2 * gk.x, c1 = kv.y * r2 * gk.y;
    *(unsigned*)(CKVB + ((size_t)ug * KVR + tu) * 128 + lane * 2) = pack2(c0, c1);
    if (isctx) {
      int b = g >> 8, t = g & 255;
      *(float2*)(p.out + O_CKV + ((size_t)(b * 2 + l) * 256 + t) * 128 + lane * 2) = make_float2(c0, c1);
    }
    float kp = KVPE[(size_t)tl * 192 + 128 + lane];
    float other = __shfl_xor(kp, 32);
    float ko = kp;
    if (!isctx) {
      int ii = lane & 31;
      float pos = ii < 16 ? (float)(tu >> 6) : (float)(tu & 63);
      float ang = pos * rope_inv(ii);
      float sn, cs;
      __sincosf(ang, &sn, &cs);
      ko = lane < 32 ? kp * cs - other * sn : other * sn + kp * cs;
    }
    KPER[((size_t)ug * KVR + tu) * 64 + lane] = f2bf(ko);
  }
}

DEV void mlatail_job(const P& p, int l, int g0, int ug, int rb) {
  const int tid = ltid();
  const int b = ((g0 >> 12) + ug) - 1;
  bf16* CKVB = (bf16*)(p.ws + W_CKVB);
  bf16* KPER = (bf16*)(p.ws + W_KPER);
  for (int i = tid; i < 32 * 128; i += 256) {
    int r = rb * 32 + (i >> 7), c = i & 127;
    CKVB[((size_t)ug * KVR + UT + r) * 128 + c] = f2bf(p.cache_ckv[((size_t)(b * 2 + l) * 256 + r) * 128 + c]);
  }
  for (int i = tid; i < 32 * 64; i += 256) {
    int r = rb * 32 + (i >> 6), c = i & 63;
    KPER[((size_t)ug * KVR + UT + r) * 64 + c] = f2bf(p.cache_kpe[((size_t)(b * 2 + l) * 256 + r) * 64 + c]);
  }
}

DEV void conv_job(const P& p, int l, int g0, int tb) {
  const int tid = ltid();
  const bf16* Z = (const bf16*)(p.ws + W_Z);
  bf16* BR = (bf16*)(p.ws + W_BR);
  const int t0 = tb * 32, g = g0 + t0;
  const int L = g < UT ? 256 : 4096;
  const int pos0 = g & (L - 1);
  const int c = tid * 2;
  float2 w0 = *(const float2*)(p.conv_w + (l * 3 + 0) * 512 + c), w1 = *(const float2*)(p.conv_w + (l * 3 + 1) * 512 + c),
         w2 = *(const float2*)(p.conv_w + (l * 3 + 2) * 512 + c);
  auto ld2 = [&](int tl, int col) { unsigned u = *(const unsigned*)(Z + (size_t)tl * ZS + col + c); return make_float2(bf2f(u & 0xffff), bf2f(u >> 16)); };
  auto uu = [&](int tl) { float2 a = ld2(tl, C_DC), b = ld2(tl, C_DX); return make_float2(a.x * b.x, a.y * b.y); };
  float2 up = pos0 > 0 ? uu(t0 - 1) : make_float2(0.f, 0.f);
  float2 uc = uu(t0);
  for (int i = 0; i < 32; ++i) {
    int tl = t0 + i;
    float2 un = (pos0 + i < L - 1) ? uu(tl + 1) : make_float2(0.f, 0.f);
    float2 bb = ld2(tl, C_DB), gg = ld2(tl, C_DG);
    float o0 = bb.x * (w0.x * up.x + w1.x * uc.x + w2.x * un.x) * gg.x;
    float o1 = bb.y * (w0.y * up.y + w1.y * uc.y + w2.y * un.y) * gg.y;
    *(unsigned*)(BR + (size_t)tl * 2048 + 1536 + c) = pack2(o0, o1);
    up = uc; uc = un;
  }
}

DEV void stage_acc(const f32x16 (&acc)[2][2], char* lds) {
  const int tid_ = ltid(); const int lane = tid_ & 63, w = tid_ >> 6, wm = w >> 1, wn = w & 1, ll = lane & 31, hh = lane >> 5;
  float* t = (float*)lds;
#pragma unroll
  for (int mi = 0; mi < 2; ++mi)
#pragma unroll
    for (int ni = 0; ni < 2; ++ni)
#pragma unroll
      for (int reg = 0; reg < 16; ++reg)
        t[(wm * 64 + mi * 32 + rowoff(reg, hh)) * 132 + wn * 64 + ni * 32 + ll] = acc[mi][ni][reg];
  __syncthreads();
}
DEV uint4 pack8(const float* v) {
  uint4 u; u.x = pack2(v[0], v[1]); u.y = pack2(v[2], v[3]); u.z = pack2(v[4], v[5]); u.w = pack2(v[6], v[7]);
  return u;
}

DEV void gemm1_job(const P& p, int l, int g0, int mt, int n0, int ncap, char* lds) {
  const int tid = ltid();
  const int m0 = mt * 128;
  {
    f32x16 acc[2][2];
    zero16(acc[0][0]); zero16(acc[0][1]); zero16(acc[1][0]); zero16(acc[1][1]);
    const bf16* A = (const bf16*)(p.ws + W_H) + (size_t)m0 * 1024;
    const bf16* Bt = (const bf16*)(p.ws + W_WIN) + ((size_t)l * ZW + n0) * 1024;
    gemm_core<128>(acc, A, 1024, Bt, 1024, ncap - n0 < 128 ? ncap - n0 : 128, 1024, lds);
    stage_acc(acc, lds);
  }
  const float* t = (const float*)lds;
  bf16* Z = (bf16*)(p.ws + W_Z);
  const bool isctx = (g0 + m0) < UT;
  const int cc = (tid & 15) * 8, cb = n0 + cc;
  if (cb < ncap) {
    int mode;
    if (cb < C_AFF) mode = 1; else if (cb < C_AFB) mode = 3; else if (cb < C_AI) mode = 4; else if (cb < C_AG) mode = 0;
    else if (cb < C_BQ) mode = 1; else if (cb < C_BK) mode = 5; else if (cb < C_BV) mode = 6; else if (cb < C_BG) mode = 7;
    else if (cb < C_QD) mode = 1; else if (cb < C_KVD) mode = 0; else if (cb < C_KPE) mode = 8; else if (cb < C_CG) mode = 9;
    else if (cb < C_DB) mode = 1; else if (cb < C_DG) mode = 0; else if (cb < C_MG) mode = 1; else mode = 2;
    float bias[8], lbv[8];
#pragma unroll
    for (int j = 0; j < 8; ++j) { bias[j] = p.b_in[l * ZW + cb + j]; lbv[j] = 0.f; }
    if ((mode == 3 || mode == 4) && l > 0) {
      int dir = mode - 3, c = cb - (dir ? C_AFB : C_AFF);
#pragma unroll
      for (int j = 0; j < 8; ++j) lbv[j] = sigm(p.lb_logits[(dir * 2 + 1) * 512 + c + j] - p.lb_logits[(dir * 2 + 0) * 512 + c + j]);
    }
#pragma unroll 1
    for (int it = 0; it < 8; ++it) {
      const int rl = it * 16 + (tid >> 4), row = m0 + rl, g = g0 + row;
      float v[8];
      {
        float4 a0 = *(const float4*)(t + rl * 132 + cc), a1 = *(const float4*)(t + rl * 132 + cc + 4);
        v[0] = a0.x + bias[0]; v[1] = a0.y + bias[1]; v[2] = a0.z + bias[2]; v[3] = a0.w + bias[3];
        v[4] = a1.x + bias[4]; v[5] = a1.y + bias[5]; v[6] = a1.z + bias[6]; v[7] = a1.w + bias[7];
      }
      const size_t octx = (size_t)((g >> 8) * 2 + l) * 256 + (g & 255);
      switch (mode) {
        case 0: *(uint4*)(Z + (size_t)row * ZS + cb) = pack8(v); break;
        case 1: {
#pragma unroll
          for (int j = 0; j < 8; ++j) v[j] = silu(v[j]);
          *(uint4*)(Z + (size_t)row * ZS + cb) = pack8(v);
        } break;
        case 2: break;
        case 3:
        case 4: {
#pragma unroll
          for (int j = 0; j < 8; ++j)
            v[j] = (lbv[j] == 0.f) ? (fminf(v[j], 0.f) - __logf(1.f + __expf(-fabsf(v[j])))) : __logf(lbv[j] + (1.f - lbv[j]) * sigm(v[j]));
          _Float16* L = (_Float16*)(p.ws + (mode == 3 ? W_LGF : W_LGB)) + (size_t)row * 512 + (cb - (mode == 3 ? C_AFF : C_AFB));
          typedef _Float16 h8 __attribute__((ext_vector_type(8)));
          h8 hv;
#pragma unroll
          for (int j = 0; j < 8; ++j) hv[j] = (_Float16)v[j];
          *(h8*)L = hv;
        } break;
        case 5: {
#pragma unroll
          for (int j = 0; j < 8; ++j) v[j] *= QS_NA;
          *(uint4*)(Z + (size_t)row * ZS + cb) = pack8(v);
        } break;
        case 6:
        case 7: {
          if (mode == 6) *(uint4*)(Z + (size_t)row * ZS + cb) = pack8(v);
          if (isctx) {
            float* o = p.out + (mode == 6 ? O_NK : O_NV) + octx * 512 + (cb - (mode == 6 ? C_BK : C_BV));
            *(float4*)o = make_float4(v[0], v[1], v[2], v[3]);
            *(float4*)(o + 4) = make_float4(v[4], v[5], v[6], v[7]);
          }
        } break;
        case 8: {
          float* o = (float*)(p.ws + W_KVPE) + (size_t)row * 192 + (cb - C_KVD);
          *(float4*)o = make_float4(v[0], v[1], v[2], v[3]);
          *(float4*)(o + 4) = make_float4(v[4], v[5], v[6], v[7]);
        } break;
        case 9: {
          float* o = (float*)(p.ws + W_KVPE) + (size_t)row * 192 + 128 + (cb - C_KPE);
          *(float4*)o = make_float4(v[0], v[1], v[2], v[3]);
          *(float4*)(o + 4) = make_float4(v[4], v[5], v[6], v[7]);
          if (isctx) {
            float* o2 = p.out + O_KPE + octx * 64 + (cb - C_KPE);
            *(float4*)o2 = make_float4(v[0], v[1], v[2], v[3]);
            *(float4*)(o2 + 4) = make_float4(v[4], v[5], v[6], v[7]);
          }
        } break;
      }
    }
  }
  if (n0 >= C_MG) {
    bf16* GTt = (bf16*)(p.ws + W_G);
    const int c = tid & 127, rb = tid >> 7;
    const float bs = p.b_in[l * ZW + n0 + c];
#pragma unroll 1
    for (int i = 0; i < 8; ++i) {
      float v[8];
#pragma unroll
      for (int j = 0; j < 8; ++j) v[j] = sigm(t[(rb * 64 + i * 8 + j) * 132 + c] + bs);
      *(uint4*)(GTt + (size_t)(n0 - C_MG + c) * GT + m0 + rb * 64 + i * 8) = pack8(v);
    }
  }
  if (n0 >= C_BV && n0 < C_BG) {
    bf16* NVT = (bf16*)(p.ws + W_NVT);
    const int c = tid & 127, rb = tid >> 7;
    const float bs = p.b_in[l * ZW + n0 + c];
#pragma unroll 1
    for (int i = 0; i < 8; ++i) {
      float v[8];
#pragma unroll
      for (int j = 0; j < 8; ++j) v[j] = t[(rb * 64 + i * 8 + j) * 132 + c] + bs;
      *(uint4*)(NVT + (size_t)(n0 - C_BV + c) * GT + m0 + rb * 64 + i * 8) = pack8(v);
    }
  }
}

DEV void gemmq_job(const P& p, int l, int g0, int mt, int nt, char* lds) {
  const int tid_ = ltid(); const int lane = tid_ & 63, w = tid_ >> 6, wm = w >> 1, wn = w & 1, ll = lane & 31, hh = lane >> 5;
  f32x16 acc[2][2];
  zero16(acc[0][0]); zero16(acc[0][1]); zero16(acc[1][0]); zero16(acc[1][1]);
  const int m0 = mt * 128, n0 = nt * 128;
  gemm_core<128>(acc, (const bf16*)(p.ws + W_QN) + (size_t)m0 * 256, 256,
                 (const bf16*)(p.ws + W_WQB) + ((size_t)l * 768 + n0) * 256, 256, 128, 256, lds);
  bf16* QM = (bf16*)(p.ws + W_QM);
  const bool isctx = (g0 + m0) < UT;
  const int cbase = n0 + wn * 64;
  const bool rope = (!isctx) && ((cbase % 192) == 128);
  const float inv = rope_inv(ll);
#pragma unroll
  for (int mi = 0; mi < 2; ++mi) {
#pragma unroll
    for (int reg = 0; reg < 16; ++reg) {
      const int row = m0 + wm * 64 + mi * 32 + rowoff(reg, hh);
      float x1 = acc[mi][0][reg] * QS_MLA, x2 = acc[mi][1][reg] * QS_MLA;
      if (rope) {
        int tu = row & 4095;
        float pos = ll < 16 ? (float)(tu >> 6) : (float)(tu & 63);
        float sn, cs;
        __sincosf(pos * inv, &sn, &cs);
        float y1 = x1 * cs - x2 * sn, y2 = x1 * sn + x2 * cs;
        x1 = y1; x2 = y2;
      }
      QM[(size_t)row * 768 + cbase + ll] = f2bf(x1);
      QM[(size_t)row * 768 + cbase + 32 + ll] = f2bf(x2);
    }
  }
}

DEV void gemmkv_job(const P& p, int l, int ug, int mt, int nt, char* lds) {
  const int tid_ = ltid(); const int lane = tid_ & 63, w = tid_ >> 6, wm = w >> 1, wn = w & 1, ll = lane & 31, hh = lane >> 5;
  f32x16 acc[2][2];
  zero16(acc[0][0]); zero16(acc[0][1]); zero16(acc[1][0]); zero16(acc[1][1]);
  const int m0 = mt * 128, n0 = nt * 128;
  gemm_core<128>(acc, (const bf16*)(p.ws + W_CKVB) + ((size_t)ug * KVR + m0) * 128, 128,
                 (const bf16*)(p.ws + W_WKVB) + ((size_t)l * 1024 + n0) * 128, 128, 128, 128, lds);
  bf16* KN = (bf16*)(p.ws + W_KN);
  bf16* VT = (bf16*)(p.ws + W_VT);
  const int hd = n0 >> 8;
  const bool isv = (n0 & 255) != 0;
#pragma unroll
  for (int mi = 0; mi < 2; ++mi)
#pragma unroll
    for (int ni = 0; ni < 2; ++ni) {
      const int cw = wn * 64 + ni * 32 + ll;
      const int rbase = m0 + wm * 64 + mi * 32;
      if (!isv) {
#pragma unroll
        for (int reg = 0; reg < 16; ++reg)
          KN[((size_t)ug * KVR + rbase + rowoff(reg, hh)) * 512 + hd * 128 + cw] = f2bf(acc[mi][ni][reg]);
      } else {
#pragma unroll
        for (int g4 = 0; g4 < 4; ++g4) {
          uint2 o; o.x = pack2(acc[mi][ni][4 * g4], acc[mi][ni][4 * g4 + 1]); o.y = pack2(acc[mi][ni][4 * g4 + 2], acc[mi][ni][4 * g4 + 3]);
          *(uint2*)(VT + ((size_t)ug * 512 + hd * 128 + cw) * KVR + rbase + 8 * g4 + 4 * hh) = o;
        }
      }
    }
}

DEV void gemm3_job(const P& p, int l, int mt, int nt, char* lds) {
  constexpr int STAGE = 256 * 128;
  const int tid = ltid(), lane = tid & 63, w = tid >> 6, wm = w >> 1, wn = w & 1, ll = lane & 31, hh = lane >> 5;
  const int m0 = mt * 128, n0 = nt * 128;
  f32x16 ms[2][2], acc[2][2];
  unsigned gp[2][2][8];
#pragma unroll
  for (int mi = 0; mi < 2; ++mi)
#pragma unroll
    for (int ni = 0; ni < 2; ++ni) { zero16(ms[mi][ni]); zero16(acc[mi][ni]); }
  const int lrow = tid >> 3, lch = (tid & 7) ^ ((tid >> 4) & 7);
  const bf16* aH = (const bf16*)(p.ws + W_H) + (size_t)(m0 + lrow) * 1024 + lch * 8;
  const bf16* aB = (const bf16*)(p.ws + W_BR) + (size_t)(m0 + lrow) * 2048 + lch * 8;
  const bf16* bG = (const bf16*)(p.ws + W_WIN) + ((size_t)l * ZW + C_MG + n0 + lrow) * 1024 + lch * 8;
  const bf16* bB = (const bf16*)(p.ws + W_WBR) + ((size_t)l * 1024 + n0 + lrow) * 2048 + lch * 8;
  char* ldst = lds + tid * 16;
  auto issue = [&](int kt, int st) {
    const int n = kt / 24, r = kt - n * 24;
    char* d = ldst + st * STAGE;
    if (r < 16) {
      const bf16* ap = aH + r * 64;
      const bf16* bp = bG + (size_t)n * 1024 * 1024 + r * 64;
#pragma unroll
      for (int i = 0; i < 4; ++i)
        __builtin_amdgcn_global_load_lds((const unsigned*)(ap + (size_t)(32 * i) * 1024), (__attribute__((address_space(3))) unsigned*)(d + i * 4096), 16, 0, 0);
#pragma unroll
      for (int i = 0; i < 4; ++i)
        __builtin_amdgcn_global_load_lds((const unsigned*)(bp + (size_t)(32 * i) * 1024), (__attribute__((address_space(3))) unsigned*)(d + 16384 + i * 4096), 16, 0, 0);
    } else {
      const bf16* ap = aB + n * 512 + (r - 16) * 64;
      const bf16* bp = bB + n * 512 + (r - 16) * 64;
#pragma unroll
      for (int i = 0; i < 4; ++i)
        __builtin_amdgcn_global_load_lds((const unsigned*)(ap + (size_t)(32 * i) * 2048), (__attribute__((address_space(3))) unsigned*)(d + i * 4096), 16, 0, 0);
#pragma unroll
      for (int i = 0; i < 4; ++i)
        __builtin_amdgcn_global_load_lds((const unsigned*)(bp + (size_t)(32 * i) * 2048), (__attribute__((address_space(3))) unsigned*)(d + 16384 + i * 4096), 16, 0, 0);
    }
  };
  const int key = (ll >> 1) & 7;
  int koff[4];
#pragma unroll
  for (int ks = 0; ks < 4; ++ks) koff[ks] = ((2 * ks + hh) ^ key) * 16;
  __syncthreads();
  issue(0, 0);
  asm volatile("s_waitcnt vmcnt(0)" ::: "memory");
  __syncthreads();
  int kt = 0;
  auto step = [&]() {
    if (kt + 1 < 96) issue(kt + 1, (kt + 1) & 1);
    const char* s = lds + (kt & 1) * STAGE;
    const char* sa = s + (wm * 64 + ll) * 128;
    const char* sb = s + 16384 + (wn * 64 + ll) * 128;
#pragma unroll
    for (int ks = 0; ks < 4; ++ks) {
      bf16x8 a0 = *(const bf16x8*)(sa + koff[ks]), a1 = *(const bf16x8*)(sa + 32 * 128 + koff[ks]);
#pragma unroll
      for (int ni = 0; ni < 2; ++ni) {
        bf16x8 bq = *(const bf16x8*)(sb + ni * 32 * 128 + koff[ks]);
        acc[0][ni] = MFMA(a0, bq, acc[0][ni]);
        acc[1][ni] = MFMA(a1, bq, acc[1][ni]);
      }
    }
    __builtin_amdgcn_sched_group_barrier(0x100, 8, 0);
    __builtin_amdgcn_sched_group_barrier(0x008, 4, 0);
    __builtin_amdgcn_sched_group_barrier(0x100, 4, 0);
    __builtin_amdgcn_sched_group_barrier(0x008, 4, 0);
    __builtin_amdgcn_sched_group_barrier(0x100, 4, 0);
    __builtin_amdgcn_sched_group_barrier(0x008, 8, 0);
    asm volatile("s_waitcnt vmcnt(0)" ::: "memory");
    __syncthreads();
    ++kt;
  };
#pragma unroll 1
  for (int n = 0; n < 4; ++n) {
#pragma unroll 1
    for (int r = 0; r < 16; ++r) step();
#pragma unroll
    for (int ni = 0; ni < 2; ++ni) {
      const float bias = p.b_in[l * ZW + C_MG + n * 1024 + n0 + wn * 64 + ni * 32 + ll];
#pragma unroll
      for (int mi = 0; mi < 2; ++mi)
#pragma unroll
        for (int k = 0; k < 8; ++k) {
          gp[mi][ni][k] = pack2(sigm(acc[mi][ni][2 * k] + bias), sigm(acc[mi][ni][2 * k + 1] + bias));
          acc[mi][ni][2 * k] = 0.f; acc[mi][ni][2 * k + 1] = 0.f;
        }
    }
#pragma unroll 1
    for (int r = 0; r < 8; ++r) step();
#pragma unroll
    for (int mi = 0; mi < 2; ++mi)
#pragma unroll
      for (int ni = 0; ni < 2; ++ni)
#pragma unroll
        for (int k = 0; k < 8; ++k) {
          ms[mi][ni][2 * k] += bf2f(gp[mi][ni][k] & 0xffff) * acc[mi][ni][2 * k];
          ms[mi][ni][2 * k + 1] += bf2f(gp[mi][ni][k] >> 16) * acc[mi][ni][2 * k + 1];
          acc[mi][ni][2 * k] = 0.f; acc[mi][ni][2 * k + 1] = 0.f;
        }
  }
  bf16* MB = (bf16*)(p.ws + W_MB);
  stage_acc(ms, lds);
  {
    const float* t = (const float*)lds;
    const int cc = (tid & 15) * 8;
#pragma unroll 1
    for (int it = 0; it < 8; ++it) {
      const int rl = it * 16 + (tid >> 4);
      float v[8];
      float4 a0 = *(const float4*)(t + rl * 132 + cc), a1 = *(const float4*)(t + rl * 132 + cc + 4);
      v[0] = a0.x; v[1] = a0.y; v[2] = a0.z; v[3] = a0.w; v[4] = a1.x; v[5] = a1.y; v[6] = a1.z; v[7] = a1.w;
      *(uint4*)(MB + (size_t)(m0 + rl) * 1024 + n0 + cc) = pack8(v);
    }
  }
}

DEV void gemm4_job(const P& p, int l, int g0, int mt, int nt, char* lds) {
  const int tid = ltid();
  const int m0 = mt * 128, n0 = nt * 128;
  {
    f32x16 acc[2][2];
    zero16(acc[0][0]); zero16(acc[0][1]); zero16(acc[1][0]); zero16(acc[1][1]);
    gemm_core<128>(acc, (const bf16*)(p.ws + W_MB) + (size_t)m0 * 1024, 1024,
                   (const bf16*)(p.ws + W_WOUT) + ((size_t)l * 1024 + n0) * 1024, 1024, 128, 1024, lds);
    stage_acc(acc, lds);
  }
  const float* t = (const float*)lds;
  const int cond = (g0 + m0) >> 12;
  const int cc = (tid & 31) * 4;
  const float4 gt = *(const float4*)((const float*)(p.ws + W_MOD) + (size_t)(l * 9 + cond) * 3072 + 2048 + n0 + cc);
#pragma unroll 1
  for (int it = 0; it < 16; ++it) {
    const int rl = it * 8 + (tid >> 5), g = g0 + m0 + rl;
    float* y = p.out + (size_t)g * 1024 + n0 + cc;
    const float4 xv = l == 0 ? *(const float4*)(xin_row(p, g) + n0 + cc) : *(const float4*)y;
    const float4 a = *(const float4*)(t + rl * 132 + cc);
    *(float4*)y = make_float4(ALPHA * xv.x + gt.x * a.x, ALPHA * xv.y + gt.y * a.y, ALPHA * xv.z + gt.z * a.z, ALPHA * xv.w + gt.w * a.w);
  }
}

template <int ET>
DEV void smax32(f32x16& x, float& m, float& lsum, f32x16 (&o)[ET]) {
  float mx = x[0];
#pragma unroll
  for (int i = 1; i < 16; ++i) mx = fmaxf(mx, x[i]);
  mx = xhalf_max(mx);
  if (__any(mx > m + 8.f)) {
    float mn = fmaxf(m, mx), al_ = ex2(m - mn);
    m = mn;
    lsum *= al_;
#pragma unroll
    for (int e = 0; e < ET; ++e)
#pragma unroll
      for (int i = 0; i < 16; ++i) o[e][i] *= al_;
  }
  float ps = 0.f;
#pragma unroll
  for (int i = 0; i < 16; ++i) { x[i] = ex2(x[i] - m); ps += x[i]; }
  lsum += ps;
}

DEV void na_wave(const P& p, int l, int g0, int ug, int qb, int h, char* lds) {
  const int tid_ = ltid(); const int lane = tid_ & 63, ll = lane & 31, hh = lane >> 5;
  float* bt = (float*)(lds + (tid_ >> 6) * 2048);
  const bf16* Z = (const bf16*)(p.ws + W_Z);
  const bf16* NVT = (const bf16*)(p.ws + W_NVT);
  const int ub = ug * UT;
  const bool isctx = (g0 + ub) < UT;
  const int tq = ub + qb * 32 + ll;
  bf16x8 qf[4];
  {
    const bf16* qp = Z + (size_t)tq * ZS + C_BQ + h * 64 + hh * 8;
#pragma unroll
    for (int ks = 0; ks < 4; ++ks) qf[ks] = *(const bf16x8*)(qp + ks * 16);
  }
  f32x16 o[2];
  zero16(o[0]); zero16(o[1]);
  float m = -1e30f, lsum = 0.f;
  const bf16 *kb, *vb;
  size_t kstride, vstride;
  if (isctx) {
    int kt0 = ub + ((qb * 32) & ~255);
    kb = Z + (size_t)kt0 * ZS + C_BK + h * 64; kstride = ZS;
    vb = NVT + (size_t)(h * 64) * GT + kt0; vstride = GT;
  } else {
    int b = ((g0 >> 12) + ug) - 1;
    kb = (const bf16*)(p.ws + W_CK) + (size_t)((b * 2 + l) * 8 + h) * 256 * 64; kstride = 64;
    vb = (const bf16*)(p.ws + W_CVT) + (size_t)((b * 2 + l) * 8 + h) * 64 * 256; vstride = 256;
  }
  const int r = qb >> 1, c = (qb & 1) * 32 + ll;
  int rs = r - 4; rs = rs < 0 ? 0 : (rs > 56 ? 56 : rs);
  int cs = c - 8; cs = cs < 0 ? 0 : (cs > 48 ? 48 : cs);
  const float* rpb = p.na_rpb + (size_t)(l * 8 + h) * 15 * 31;
  if (!isctx) {
    for (int i = lane; i < 465; i += 64) bt[i] = rpb[i] * LOG2E;
  }
  const int nt = isctx ? 8 : 24;
  char* kl = lds + 8192 + (tid_ >> 6) * 8192;
  char* vl = kl + 4096;
  const int krow = lane >> 3, kch = lane & 7, vrow = lane >> 2, vch = lane & 3;
  uint4 kr0, kr1, kr2, kr3, vr0, vr1, vr2, vr3;
#define NA_LOAD(i_)                                                                                        \
  {                                                                                                        \
    const bf16 *kp_, *vp_;                                                                                 \
    size_t ks_, vs_;                                                                                       \
    if ((i_) < 8) { kp_ = kb + (size_t)((i_) * 32) * kstride; ks_ = kstride; vp_ = vb + (i_) * 32; vs_ = vstride; } \
    else {                                                                                                 \
      const int j_ = (i_) - 8, kt0_ = ub + (rs + (j_ >> 1)) * 64 + (j_ & 1) * 32;                          \
      kp_ = Z + (size_t)kt0_ * ZS + C_BK + h * 64; ks_ = ZS;                                               \
      vp_ = NVT + (size_t)(h * 64) * GT + kt0_; vs_ = GT;                                                  \
    }                                                                                                      \
    kp_ += (size_t)krow * ks_ + kch * 8; vp_ += (size_t)vrow * vs_ + vch * 8;                              \
    kr0 = *(const uint4*)(kp_); kr1 = *(const uint4*)(kp_ + 8 * ks_);                                      \
    kr2 = *(const uint4*)(kp_ + 16 * ks_); kr3 = *(const uint4*)(kp_ + 24 * ks_);                          \
    vr0 = *(const uint4*)(vp_); vr1 = *(const uint4*)(vp_ + 16 * vs_);                                     \
    vr2 = *(const uint4*)(vp_ + 32 * vs_); vr3 = *(const uint4*)(vp_ + 48 * vs_);                          \
  }
  const int kw0 = krow * 128, kx_ = krow >> 1, vw0 = vrow * 64 + ((vch ^ ((vrow >> 2) & 3)) << 4);
  const int kfo = ll * 128, kfx = (ll >> 1) & 7, vfx = (ll >> 2) & 3;
  NA_LOAD(0)
  for (int i = 0; i < nt; ++i) {
    *(uint4*)(kl + kw0 + ((kch ^ (kx_ & 7)) << 4)) = kr0;
    *(uint4*)(kl + kw0 + 1024 + ((kch ^ ((kx_ + 4) & 7)) << 4)) = kr1;
    *(uint4*)(kl + kw0 + 2048 + ((kch ^ (kx_ & 7)) << 4)) = kr2;
    *(uint4*)(kl + kw0 + 3072 + ((kch ^ ((kx_ + 4) & 7)) << 4)) = kr3;
    *(uint4*)(vl + vw0) = vr0; *(uint4*)(vl + vw0 + 1024) = vr1; *(uint4*)(vl + vw0 + 2048) = vr2; *(uint4*)(vl + vw0 + 3072) = vr3;
    { const int inx = i + 1 < nt ? i + 1 : i; NA_LOAD(inx) }
    f32x16 x;
    zero16(x);
#pragma unroll
    for (int ks = 0; ks < 4; ++ks) x = MFMA(*(const bf16x8*)(kl + kfo + (((2 * ks + hh) ^ kfx) << 4)), qf[ks], x);
    if (i >= 8) {
      const int j8 = i - 8, half = j8 & 1, kr = rs + (j8 >> 1);
      const float* rp = bt + (kr - r + 7) * 31 + 15 - c;
#pragma unroll
      for (int reg = 0; reg < 16; ++reg) {
        int j = half * 32 + rowoff(reg, hh);
        bool ok = (j >= cs) && (j < cs + 16);
        int jc = j < c - 15 ? c - 15 : (j > c + 15 ? c + 15 : j);
        x[reg] = x[reg] + rp[jc] + (ok ? 0.f : -1e30f);
      }
    }
    smax32<2>(x, m, lsum, o);
#pragma unroll
    for (int s2 = 0; s2 < 2; ++s2) {
      bf16x8 pf = packf8(x, s2);
#pragma unroll
      for (int e = 0; e < 2; ++e) {
        const char* vp = vl + (e * 32 + ll) * 64 + 8 * hh;
        o[e] = MFMA(comb(*(const uint2*)(vp + (((2 * s2) ^ vfx) << 4)), *(const uint2*)(vp + (((2 * s2 + 1) ^ vfx) << 4))), pf, o[e]);
      }
    }
  }
  float lt = lsum + __shfl_xor(lsum, 32);
  float inv = 1.f / lt;
  bf16* BR = (bf16*)(p.ws + W_BR);
#pragma unroll
  for (int e = 0; e < 2; ++e)
#pragma unroll
    for (int g4 = 0; g4 < 4; ++g4) {
      int ee = h * 64 + e * 32 + 8 * g4 + 4 * hh;
      uint2 gr = *(const uint2*)(Z + (size_t)tq * ZS + C_BG + ee);
      uint2 ov;
      ov.x = pack2(o[e][4 * g4] * inv * bf2f(gr.x & 0xffff), o[e][4 * g4 + 1] * inv * bf2f(gr.x >> 16));
      ov.y = pack2(o[e][4 * g4 + 2] * inv * bf2f(gr.y & 0xffff), o[e][4 * g4 + 3] * inv * bf2f(gr.y >> 16));
      *(uint2*)(BR + (size_t)tq * 2048 + 512 + ee) = ov;
    }
}

DEV void mla_job(const P& p, int g0, int ug, int qblk, int h, char* lds) {
  const int tid = ltid(), lane = tid & 63, w = tid >> 6, ll = lane & 31, hh = lane >> 5;
  const int ub = ug * UT;
  const bool isctx = (g0 + ub) < UT;
  const int tq = ub + qblk * 128 + w * 32 + ll;
  bf16x8 qf[12];
  {
    const bf16* qp = (const bf16*)(p.ws + W_QM) + (size_t)tq * 768 + h * 192 + hh * 8;
#pragma unroll
    for (int ks = 0; ks < 12; ++ks) qf[ks] = *(const bf16x8*)(qp + ks * 16);
  }
  const int key_lo = isctx ? (qblk >> 1) * 256 : 0, ntiles = isctx ? 8 : 136;
  const bf16* KNb = (const bf16*)(p.ws + W_KN) + (size_t)ug * KVR * 512 + h * 128;
  const bf16* KPb = (const bf16*)(p.ws + W_KPER) + (size_t)ug * KVR * 64;
  const bf16* VTb = (const bf16*)(p.ws + W_VT) + ((size_t)ug * 512 + h * 128) * KVR;
  const bf16* kptr[3];
  int kstr[3];
#pragma unroll
  for (int i = 0; i < 3; ++i) {
    int L = tid * 16 + i * 4096, row = L / 384, pos = (L - row * 384) >> 4, c = pos ^ ((row >> 1) & 7);
    if (c < 16) { kptr[i] = KNb + (size_t)(key_lo + row) * 512 + c * 8; kstr[i] = 32 * 512; }
    else { kptr[i] = KPb + (size_t)(key_lo + row) * 64 + (c - 16) * 8; kstr[i] = 32 * 64; }
  }
  const bf16* vptr[2];
#pragma unroll
  for (int i = 0; i < 2; ++i) {
    int e = (tid >> 2) + 64 * i, c = (tid & 3) ^ ((tid >> 4) & 3);
    vptr[i] = VTb + (size_t)e * KVR + key_lo + c * 8;
  }
  char* ldst = lds + tid * 16;
#define MLA_ISSUE(t)                                                                                                         \
  {                                                                                                                          \
    const int ks_ = (t) % 3, vs_ = (t) & 3;                                                                                  \
    _Pragma("unroll") for (int i = 0; i < 3; ++i) __builtin_amdgcn_global_load_lds(                                          \
        (const unsigned*)(kptr[i] + (size_t)(t) * kstr[i]), (__attribute__((address_space(3))) unsigned*)(ldst + ks_ * 12288 + i * 4096), 16, 0, 0); \
    _Pragma("unroll") for (int i = 0; i < 2; ++i) __builtin_amdgcn_global_load_lds(                                          \
        (const unsigned*)(vptr[i] + (size_t)(t) * 32), (__attribute__((address_space(3))) unsigned*)(ldst + 36864 + vs_ * 8192 + i * 4096), 16, 0, 0); \
  }
#define MLA_S(xout, t)                                                                                                       \
  {                                                                                                                          \
    const char* S_ = lds + ((t) % 3) * 12288;                                                                                \
    zero16(xout);                                                                                                            \
    _Pragma("unroll") for (int ks = 0; ks < 12; ++ks)                                                                        \
      xout = MFMA(*(const bf16x8*)(S_ + (ks >> 2) * 128 + klo[ks & 3]), qf[ks], xout);                                       \
  }
  const int kx = (ll >> 1) & 7, vx = (ll >> 2) & 3;
  int klo[4];
#pragma unroll
  for (int ks = 0; ks < 4; ++ks) klo[ks] = ll * 384 + (((2 * ks + hh) ^ kx) << 4);
  int vo[4];
#pragma unroll
  for (int c = 0; c < 4; ++c) vo[c] = 36864 + ll * 64 + ((c ^ vx) << 4) + 8 * hh;
  f32x16 o[4];
  zero16(o[0]); zero16(o[1]); zero16(o[2]); zero16(o[3]);
  float m = -1e30f, lsum = 0.f;
  const unsigned lds_base = lds_addr(lds);
  __syncthreads();
  MLA_ISSUE(0)
  MLA_ISSUE(1)
  MLA_ISSUE(2)
  asm volatile("s_waitcnt vmcnt(12)" ::: "memory");
  __builtin_amdgcn_s_barrier();
  f32x16 x;
  MLA_S(x, 0)
  for (int t = 0; t < ntiles; ++t) {
    if (t + 2 < ntiles) asm volatile("s_waitcnt vmcnt(7)" ::: "memory");
    else if (t + 1 < ntiles) asm volatile("s_waitcnt vmcnt(2)" ::: "memory");
    else asm volatile("s_waitcnt vmcnt(0)" ::: "memory");
    __builtin_amdgcn_s_barrier();
    if (t + 3 < ntiles) MLA_ISSUE(t + 3)
    f32x16 xn;
    if (t + 1 < ntiles) MLA_S(xn, t + 1)
    float mx = x[0];
#pragma unroll
    for (int i = 1; i < 16; ++i) mx = fmaxf(mx, x[i]);
    mx = xhalf_max(mx);
    if (__any(mx > m + 8.f)) {
      float mn = fmaxf(m, mx), al_ = ex2(m - mn);
      m = mn;
      lsum *= al_;
#pragma unroll
      for (int e = 0; e < 4; ++e)
#pragma unroll
        for (int i = 0; i < 16; ++i) o[e][i] *= al_;
    }
    float ps = 0.f;
#pragma unroll
    for (int i = 0; i < 16; ++i) { x[i] = ex2(x[i] - m); ps += x[i]; }
    lsum += ps;
    const unsigned vb_ = lds_base + (t & 3) * 8192;
#pragma unroll
    for (int s = 0; s < 2; ++s) {
      u32x2 vr[4][2];
#pragma unroll
      for (int e = 0; e < 4; ++e) { vr[e][0] = lds_rd64(vb_ + e * 2048 + vo[2 * s]); vr[e][1] = lds_rd64(vb_ + e * 2048 + vo[2 * s + 1]); }
      bf16x8 pf = packf8(x, s);
      asm volatile("s_waitcnt lgkmcnt(0)"
                   : "+v"(vr[0][0]), "+v"(vr[0][1]), "+v"(vr[1][0]), "+v"(vr[1][1]), "+v"(vr[2][0]), "+v"(vr[2][1]), "+v"(vr[3][0]), "+v"(vr[3][1]));
#pragma unroll
      for (int e = 0; e < 4; ++e) o[e] = MFMA(comb2(vr[e][0], vr[e][1]), pf, o[e]);
    }
    if (t + 1 < ntiles) {
#pragma unroll
      for (int i = 0; i < 16; ++i) x[i] = xn[i];
    }
  }
  float lt = lsum + __shfl_xor(lsum, 32);
  float inv = 1.f / lt;
  const bf16* Z = (const bf16*)(p.ws + W_Z);
  bf16* BR = (bf16*)(p.ws + W_BR);
#pragma unroll
  for (int e = 0; e < 4; ++e)
#pragma unroll
    for (int g4 = 0; g4 < 4; ++g4) {
      int ee = h * 128 + e * 32 + 8 * g4 + 4 * hh;
      uint2 gr = *(const uint2*)(Z + (size_t)tq * ZS + C_CG + ee);
      uint2 ov;
      ov.x = pack2(o[e][4 * g4] * inv * bf2f(gr.x & 0xffff), o[e][4 * g4 + 1] * inv * bf2f(gr.x >> 16));
      ov.y = pack2(o[e][4 * g4 + 2] * inv * bf2f(gr.y & 0xffff), o[e][4 * g4 + 3] * inv * bf2f(gr.y >> 16));
      *(uint2*)(BR + (size_t)tq * 2048 + 1024 + ee) = ov;
    }
}

#define HG_SCAN(LGPTR)                                                                     \
  float lgv[32];                                                                           \
  _Pragma("unroll") for (int r = 0; r < 32; ++r) lgv[r] = (LGPTR)[(size_t)r * 512];        \
  {                                                                                        \
    float run = 0.f;                                                                       \
    _Pragma("unroll") for (int r = 0; r < 32; ++r) run += lgv[r];                          \
    sTot[hf * 128 + d] = run;                                                              \
  }                                                                                        \
  __syncthreads();                                                                         \
  const float t0_ = sTot[d], t1_ = sTot[128 + d], tot = t0_ + t1_;                         \
  const float cm = dir == 0 ? t0_ : t1_;                                                   \
  float bb = dir == 0 ? (hf == 1 ? t0_ : 0.f) : (hf == 0 ? t1_ : 0.f);

#define HG_SCAN2(LGPTR)                                                                    \
  {                                                                                        \
    float run = 0.f;                                                                       \
    _Pragma("unroll 16") for (int r = 0; r < 32; ++r) run += (LGPTR)[(size_t)r * 512];     \
    sTot[hf * 128 + d] = run;                                                              \
  }                                                                                        \
  __syncthreads();                                                                         \
  const float t0_ = sTot[d], t1_ = sTot[128 + d];                                          \
  const float cm = dir == 0 ? t0_ : t1_;                                                   \
  float bb = dir == 0 ? (hf == 1 ? t0_ : 0.f) : (hf == 0 ? t1_ : 0.f);

DEV void hgrn_a(const P& p, int cid, int h, int dir, char* lds) {
  const int tid = ltid(), lane = tid & 63, w = tid >> 6, ll = lane & 31, hh = lane >> 5;
  const int d = tid & 127, hf = tid >> 7;
  bf16* kT = (bf16*)lds;
  bf16* vT = (bf16*)(lds + 128 * 144);
  float* sTot = (float*)(lds + 2 * 128 * 144);
  const int tl0 = cid * 64 + hf * 32;
  const int idx = (cid * 4 + h) * 2 + dir;
  const _Float16* LG = (const _Float16*)(p.ws + (dir ? W_LGB : W_LGF)) + (size_t)tl0 * 512 + h * 128 + d;
  __syncthreads();
  HG_SCAN(LG)
  {
    const bf16* vp = (const bf16*)(p.ws + W_Z) + (size_t)tl0 * ZS + C_AI + h * 128 + d;
    bf16 vv[32];
#pragma unroll
    for (int r = 0; r < 32; ++r) vv[r] = vp[(size_t)r * ZS];
    if (dir == 0) {
#pragma unroll
      for (int r = 0; r < 32; ++r) { const float lg = lgv[r]; bb += lg; kT[d * 72 + hf * 32 + r] = f2bf(-expm1f(lg) * __expf(tot - bb)); }
    } else {
#pragma unroll
      for (int r = 31; r >= 0; --r) { const float lg = lgv[r]; bb += lg; kT[d * 72 + hf * 32 + r] = f2bf(-expm1f(lg) * __expf(tot - bb)); }
    }
#pragma unroll
    for (int r = 0; r < 32; ++r) vT[d * 72 + hf * 32 + r] = vv[r];
  }
  if (hf == 0) {
    ((float*)(p.ws + W_BL))[(size_t)idx * 128 + d] = tot;
    ((float*)(p.ws + W_CM))[(size_t)idx * 128 + d] = cm;
  }
  __syncthreads();
  f32x16 acc[4];
  zero16(acc[0]); zero16(acc[1]); zero16(acc[2]); zero16(acc[3]);
#pragma unroll
  for (int ks = 0; ks < 4; ++ks) {
    bf16x8 a = *(const bf16x8*)(vT + (w * 32 + ll) * 72 + ks * 16 + hh * 8);
#pragma unroll
    for (int it = 0; it < 4; ++it) acc[it] = MFMA(a, *(const bf16x8*)(kT + (it * 32 + ll) * 72 + ks * 16 + hh * 8), acc[it]);
  }
  bf16* SU = (bf16*)(p.ws + W_SU) + (size_t)idx * 16384;
#pragma unroll
  for (int it = 0; it < 4; ++it)
#pragma unroll
    for (int reg = 0; reg < 16; ++reg) SU[(w * 32 + rowoff(reg, hh)) * 128 + it * 32 + ll] = f2bf(acc[it][reg]);
}

template <int UN>
DEV void hgrn_b(const P& p, int l, int cbase, int NC, int h, int dir, int es, const float* s0, float* sout, char* lds) {
  const int tid = ltid();
  const int e = es * 16 + (tid >> 4), i0 = (tid & 15) * 8;
  float S[8];
  float* tb_ = (float*)lds;
  const int ti_ = tid >> 1, th_ = (tid & 1) * 8;
  if (s0) {
    const float4 a0 = *(const float4*)(s0 + (size_t)ti_ * 128 + es * 16 + th_), a1 = *(const float4*)(s0 + (size_t)ti_ * 128 + es * 16 + th_ + 4);
    float* d = tb_ + ti_ * 17 + th_;
    d[0] = a0.x; d[1] = a0.y; d[2] = a0.z; d[3] = a0.w; d[4] = a1.x; d[5] = a1.y; d[6] = a1.z; d[7] = a1.w;
    __syncthreads();
#pragma unroll
    for (int j = 0; j < 8; ++j) S[j] = tb_[(i0 + j) * 17 + (tid >> 4)];
  } else {
#pragma unroll
    for (int j = 0; j < 8; ++j) S[j] = 0.f;
  }
  bf16* SU = (bf16*)(p.ws + W_SU);
  const float* BL = (const float*)(p.ws + W_BL);
  const float* CM = (const float*)(p.ws + W_CM);
  for (int n0 = 0; n0 < NC; n0 += UN) {
    uint4 U[UN];
    float4 bl[UN][2], cmv[UN][2];
#pragma unroll
    for (int q = 0; q < UN; ++q) {
      int n = n0 + q, cid = dir == 0 ? cbase + n : cbase + NC - 1 - n;
      size_t idx = (size_t)(cid * 4 + h) * 2 + dir;
      U[q] = *(const uint4*)(SU + idx * 16384 + e * 128 + i0);
      bl[q][0] = *(const float4*)(BL + idx * 128 + i0); bl[q][1] = *(const float4*)(BL + idx * 128 + i0 + 4);
      cmv[q][0] = *(const float4*)(CM + idx * 128 + i0); cmv[q][1] = *(const float4*)(CM + idx * 128 + i0 + 4);
    }
#pragma unroll
    for (int q = 0; q < UN; ++q) {
      int n = n0 + q, cid = dir == 0 ? cbase + n : cbase + NC - 1 - n;
      size_t idx = (size_t)(cid * 4 + h) * 2 + dir;
      const float* blf = (const float*)&bl[q][0];
      const float* cmf = (const float*)&cmv[q][0];
      const unsigned* uu = (const unsigned*)&U[q];
      uint4 o;
      unsigned* op = (unsigned*)&o;
#pragma unroll
      for (int j = 0; j < 8; j += 2) op[j >> 1] = pack2(S[j] * __expf(cmf[j]), S[j + 1] * __expf(cmf[j + 1]));
      *(uint4*)(SU + idx * 16384 + e * 128 + i0) = o;
#pragma unroll
      for (int j = 0; j < 8; ++j) {
        float uv = bf2f((bf16)((uu[j >> 1] >> ((j & 1) * 16)) & 0xffff));
        S[j] = __expf(blf[j]) * S[j] + uv;
      }
    }
  }
  if (sout) {
#pragma unroll
    for (int j = 0; j < 8; ++j) tb_[(i0 + j) * 17 + (tid >> 4)] = S[j];
    __syncthreads();
    const float* d = tb_ + ti_ * 17 + th_;
    *(float4*)(sout + (size_t)ti_ * 128 + es * 16 + th_) = make_float4(d[0], d[1], d[2], d[3]);
    *(float4*)(sout + (size_t)ti_ * 128 + es * 16 + th_ + 4) = make_float4(d[4], d[5], d[6], d[7]);
  }
}

DEV void hgrn_c(const P& p, int l, int cid, int h, char* lds) {
  const int tid = ltid(), lane = tid & 63, w = tid >> 6, ll = lane & 31, hh = lane >> 5;
  const int d = tid & 127, hf = tid >> 7;
  const int tt = w & 1, eh = w >> 1;
  bf16* qd = (bf16*)lds;
  bf16* kd = (bf16*)(lds + 64 * 272);
  bf16* vT = (bf16*)(lds + 2 * 64 * 272);
  float* sTot = (float*)(lds + 2 * 64 * 272 + 128 * 144);
  float* red = sTot + 256;
  const bf16* Z = (const bf16*)(p.ws + W_Z);
  const int tl0 = cid * 64 + hf * 32;
  f32x16 o[2];
  zero16(o[0]); zero16(o[1]);
#pragma unroll 1
  for (int dir = 0; dir < 2; ++dir) {
    const int idx = (cid * 4 + h) * 2 + dir;
    const _Float16* LG = (const _Float16*)(p.ws + (dir ? W_LGB : W_LGF)) + (size_t)tl0 * 512 + h * 128 + d;
    __syncthreads();
    bf16x8 sfr[2][8];
    {
      const bf16* Sg = (const bf16*)(p.ws + W_SU) + (size_t)idx * 16384;
#pragma unroll
      for (int e2 = 0; e2 < 2; ++e2)
#pragma unroll
        for (int ks = 0; ks < 8; ++ks) sfr[e2][ks] = *(const bf16x8*)(Sg + ((eh * 2 + e2) * 32 + ll) * 128 + ks * 16 + hh * 8);
    }
    const float tot_ = ((const float*)(p.ws + W_BL))[(size_t)idx * 128 + d], cm = ((const float*)(p.ws + W_CM))[(size_t)idx * 128 + d];
    const float t0_ = dir == 0 ? cm : tot_ - cm, t1_ = dir == 0 ? tot_ - cm : cm;
    float bb = dir == 0 ? (hf == 1 ? t0_ : 0.f) : (hf == 0 ? t1_ : 0.f);
    {
      const bf16* qp = Z + (size_t)tl0 * ZS + C_AQ + h * 128 + d;
      const bf16* vp = Z + (size_t)tl0 * ZS + C_AI + h * 128 + d;
#pragma unroll
      for (int rr = 0; rr < 32; ++rr) {
        const int r = dir == 0 ? rr : 31 - rr;
        const float lg = LG[(size_t)r * 512];
        bb += lg;
        const float qv = bf2f(qp[(size_t)r * ZS]);
        qd[(hf * 32 + r) * 136 + d] = f2bf(qv * __expf(bb - cm));
        kd[(hf * 32 + r) * 136 + d] = f2bf(-expm1f(lg) * __expf(cm - bb));
        if (dir == 0) vT[d * 72 + hf * 32 + r] = vp[(size_t)r * ZS];
      }
    }
    __syncthreads();
    bf16x8 qf[8];
#pragma unroll
    for (int ks = 0; ks < 8; ++ks) qf[ks] = *(const bf16x8*)(qd + (tt * 32 + ll) * 136 + ks * 16 + hh * 8);
#pragma unroll
    for (int st = 0; st < 2; ++st) {
      const bool use = dir == 0 ? (st <= tt) : (st >= tt);
      if (!use) continue;
      f32x16 x;
      zero16(x);
#pragma unroll
      for (int ks = 0; ks < 8; ++ks) x = MFMA(*(const bf16x8*)(kd + (st * 32 + ll) * 136 + ks * 16 + hh * 8), qf[ks], x);
      if (st == tt) {
#pragma unroll
        for (int reg = 0; reg < 16; ++reg) {
          int sl = rowoff(reg, hh);
          bool keep = dir == 0 ? (sl <= ll) : (sl >= ll);
          x[reg] = keep ? x[reg] : 0.f;
        }
      }
#pragma unroll
      for (int s2 = 0; s2 < 2; ++s2) {
        bf16x8 pf = packf8n(x, s2);
#pragma unroll
        for (int e2 = 0; e2 < 2; ++e2) {
          const bf16* vp = vT + ((eh * 2 + e2) * 32 + ll) * 72 + st * 32 + 16 * s2 + 4 * hh;
          o[e2] = MFMA(comb(*(const uint2*)vp, *(const uint2*)(vp + 8)), pf, o[e2]);
        }
      }
    }
#pragma unroll
    for (int e2 = 0; e2 < 2; ++e2)
#pragma unroll
      for (int ks = 0; ks < 8; ++ks) o[e2] = MFMA(sfr[e2][ks], qf[ks], o[e2]);
  }
  float ss = 0.f;
#pragma unroll
  for (int e2 = 0; e2 < 2; ++e2)
#pragma unroll
    for (int i = 0; i < 16; ++i) ss += o[e2][i] * o[e2][i];
  ss += __shfl_xor(ss, 32);
  if (hh == 0) red[eh * 64 + tt * 32 + ll] = ss;
  __syncthreads();
  const float rstd = rsqrtf((red[tt * 32 + ll] + red[64 + tt * 32 + ll]) * (1.f / 128.f) + EPS);
  const int tl = cid * 64 + tt * 32 + ll;
  bf16* BR = (bf16*)(p.ws + W_BR);
#pragma unroll
  for (int e2 = 0; e2 < 2; ++e2)
#pragma unroll
    for (int g4 = 0; g4 < 4; ++g4) {
      int e = (eh * 2 + e2) * 32 + 8 * g4 + 4 * hh;
      float4 ng = *(const float4*)(p.hg_norm_g + l * 128 + e);
      uint2 gr = *(const uint2*)(Z + (size_t)tl * ZS + C_AG + h * 128 + e);
      uint2 ov;
      ov.x = pack2(o[e2][4 * g4] * rstd * ng.x * bf2f(gr.x & 0xffff), o[e2][4 * g4 + 1] * rstd * ng.y * bf2f(gr.x >> 16));
      ov.y = pack2(o[e2][4 * g4 + 2] * rstd * ng.z * bf2f(gr.y & 0xffff), o[e2][4 * g4 + 3] * rstd * ng.w * bf2f(gr.y >> 16));
      *(uint2*)(BR + (size_t)tl * 2048 + h * 128 + e) = ov;
    }
}

#define XB_TMO      128
#define XB_XCNT(j)  (256  + 64 * (j))
#define XB_XSUB(j)  (1280 + 64 * (j))
#define XB_XGEN(j)  (2304 + 64 * (j))
#define XB_TOP      3328
#define XB_TOPGEN   3392
#define XCD_BAR_WORDS 3456
#define XB_SPIN_CAP (1u << 18)
#define LAS __attribute__((address_space(3)))

__device__ __forceinline__ unsigned xb_ld(unsigned* p)              { return __hip_atomic_load(p, __ATOMIC_RELAXED, __HIP_MEMORY_SCOPE_AGENT); }
__device__ __forceinline__ unsigned xb_add(unsigned* p, unsigned v) { return __hip_atomic_fetch_add(p, v, __ATOMIC_RELAXED, __HIP_MEMORY_SCOPE_AGENT); }
__device__ __forceinline__ unsigned xb_xcc_id() { return (unsigned)__builtin_amdgcn_s_getreg((3 << 11) | 20) & 0xFu; }
#define XB_SPIN(cond, bar) do { unsigned _sp = 0; while (cond) { __builtin_amdgcn_s_sleep(1); \
    if ((++_sp & 255u) == 0u) { if (xb_ld(&(bar)[XB_TMO])) break; if (_sp > XB_SPIN_CAP) { atomicAdd(&(bar)[XB_TMO], 1u); break; } } } } while (0)

struct XcdBarrier {
    unsigned* bar; unsigned x;
    volatile LAS unsigned* st;
};

__device__ __forceinline__ XcdBarrier xcd_barrier_post(unsigned* bar, volatile LAS unsigned* st) {
    XcdBarrier b; b.bar = bar; b.x = xb_xcc_id(); b.st = st;
    if (threadIdx.x == 0) (void)xb_add(&bar[XB_XCNT(b.x)], 1u);
    return b;
}
__device__ __forceinline__ void xcd_barrier_complete(unsigned* bar, unsigned x, unsigned& nloc, unsigned& nx) {
    const unsigned G = gridDim.x * gridDim.y * gridDim.z;
    unsigned sum, cnt, mine, sp = 0u;
    for (;;) {
        sum = 0u; cnt = 0u; mine = 0u;
#pragma unroll
        for (unsigned j = 0; j < 16; ++j) { const unsigned c = xb_ld(&bar[XB_XCNT(j)]); sum += c; cnt += (c > 0u) ? 1u : 0u; mine = (j == x) ? c : mine; }
        if (sum == G) break;
        __builtin_amdgcn_s_sleep(1);
        if ((++sp & 255u) == 0u) { if (xb_ld(&bar[XB_TMO])) break; if (sp > XB_SPIN_CAP) { atomicAdd(&bar[XB_TMO], 1u); break; } }
    }
    nloc = mine > 0u ? mine : 1u; nx = cnt > 0u ? cnt : 1u;
}

__device__ __forceinline__ void xcd_barrier(const XcdBarrier& b) {
    asm volatile("s_waitcnt vmcnt(0)" ::: "memory");
    __syncthreads();
    if (threadIdx.x == 0) {
        unsigned* bar = b.bar;
        __builtin_amdgcn_s_waitcnt(0);
        unsigned nloc = b.st[0], nx = b.st[1];
        if (nloc == 0u) { xcd_barrier_complete(bar, b.x, nloc, nx); b.st[0] = nloc; b.st[1] = nx; }
        const unsigned old = xb_add(&bar[XB_XSUB(b.x)], 1u);
        const unsigned gen = old / nloc;
        if (old + 1u == (gen + 1u) * nloc) {
            __builtin_amdgcn_fence(__ATOMIC_RELEASE, "agent");
            asm volatile("s_waitcnt vmcnt(0)" ::: "memory");
            const unsigned og = xb_add(&bar[XB_TOP], 1u);
            const unsigned tg = og / nx;
            if (og + 1u == (tg + 1u) * nx) xb_add(&bar[XB_TOPGEN], 1u);
            else XB_SPIN(xb_ld(&bar[XB_TOPGEN]) == tg, bar);
            __builtin_amdgcn_fence(__ATOMIC_ACQUIRE, "agent");
            xb_add(&bar[XB_XGEN(b.x)], 1u);
            asm volatile("s_waitcnt vmcnt(0)" ::: "memory");
        } else {
            XB_SPIN(xb_ld(&bar[XB_XGEN(b.x)]) == gen, bar);
            __builtin_amdgcn_fence(__ATOMIC_ACQUIRE, "agent");
            asm volatile("s_waitcnt vmcnt(0)" ::: "memory");
        }
    }
    __syncthreads();
}


DEV int next_job(unsigned* ctr, int* sjob) {
  __syncthreads();
  if (threadIdx.x == 0) *sjob = (int)atomicAdd(ctr, 1u);
  __syncthreads();
  return *sjob;
}

__global__ void __launch_bounds__(256, 2) mega(P p) {
  extern __shared__ __attribute__((aligned(16))) char lds[];
  cg::grid_group grid = cg::this_grid();
  const int nb = gridDim.x, bid = blockIdx.x;
  __shared__ uint4 xb_words;
  int* sjob = (int*)&xb_words + 2;
  unsigned* qctr = (unsigned*)(p.ws + W_CTR) + 3584;
  if (threadIdx.x == 0) xb_words = make_uint4(0u, 0u, 0u, 0u);
  __syncthreads();
  XcdBarrier xb = xcd_barrier_post((unsigned*)(p.ws + W_CTR), (volatile LAS unsigned*)&xb_words);

  {
    const int J0 = 2 * 16 * 183, J1 = J0 + 8 * 8 * 16, J2 = J1 + 2 * 16 * 16, J3 = J2 + 2 * 4 * 12, J4 = J3 + 2 * 2 * 16,
              J5 = J4 + 96, J6 = J5 + 128;
    for (int job = bid; job < J6; job += nb) {
      if (job < J0) {
        int l = job / (16 * 183), r = job % (16 * 183);
        tr_tile(p.w_in + (size_t)l * 1024 * ZW, (bf16*)(p.ws + W_WIN) + (size_t)l * ZW * 1024, 1024, ZW, r & 15, r >> 4, lds);
      } else if (job < J1) {
        int j = job - J0, mtx = j >> 7, r = j & 127;
        tr_tile(p.w_branch + (size_t)mtx * 512 * 1024, (bf16*)(p.ws + W_WBR) + (size_t)(mtx >> 2) * 1024 * 2048 + (mtx & 3) * 512, 512, 1024, r & 7, r >> 3, lds, 2048);
      } else if (job < J2) {
        int j = job - J1, l = j >> 8, r = j & 255;
        tr_tile(p.w_out + (size_t)l * 1024 * 1024, (bf16*)(p.ws + W_WOUT) + (size_t)l * 1024 * 1024, 1024, 1024, r & 15, r >> 4, lds);
      } else if (job < J3) {
        int j = job - J2, l = j / 48, r = j % 48;
        tr_tile(p.w_qb + (size_t)l * 256 * 768, (bf16*)(p.ws + W_WQB) + (size_t)l * 768 * 256, 256, 768, r & 3, r >> 2, lds);
      } else if (job < J4) {
        int j = job - J3, l = j >> 5, r = j & 31;
        tr_tile(p.w_kvb + (size_t)l * 128 * 1024, (bf16*)(p.ws + W_WKVB) + (size_t)l * 1024 * 128, 128, 1024, r & 1, r >> 1, lds);
      } else if (job < J5) {
        int j = job - J4;
        mod_job(p, j / 48, j % 48, lds);
      } else {
        cache_job(p, job - J5, lds);
      }
    }
  }
  grid.sync();

  for (int grp = 0; grp < 9 / GU; ++grp) {
    const int u0 = grp * GU, nu = GU, g0 = u0 * UT;
    const int nlat = (grp == 0) ? nu - 1 : nu;
    const int ulat0 = (grp == 0) ? 1 : 0;
    const int MT = nu * 32;
    for (int job = bid; job < nu * 256; job += nb) h_job(p, 0, g0, job);
    xcd_barrier(xb);
    for (int l = 0; l < 2; ++l) {
      {
        const int mpx = MT >> 3, xq = bid & 7, local = bid >> 3, npl = (nb >> 3) / mpx;
        if (local < npl * mpx)
          for (int nt = local / mpx; nt < 60; nt += npl) gemm1_job(p, l, g0, xq * mpx + local % mpx, nt * 128, C_MG, lds);
      }
      xcd_barrier(xb);
      {
        const int J1 = nu * 512, J2 = J1 + nu * 128, J3 = J2 + nlat * 8, J4 = J3 + nu * 128;
        unsigned* ctr = qctr++;
        for (int job = next_job(ctr, sjob); job < J4; job = next_job(ctr, sjob)) {
          if (job < J1) {
            hgrn_a(p, job >> 3, (job >> 1) & 3, job & 1, lds);
          } else if (job < J2) {
            mlaprep_job(p, l, g0, job - J1);
          } else if (job < J3) {
            int j = job - J2;
            mlatail_job(p, l, g0, ulat0 + (j >> 3), j & 7);
          } else {
            conv_job(p, l, g0, job - J3);
          }
        }
      }
      xcd_barrier(xb);
      {
        const int nctx = nu - nlat;
        const int J0 = nlat * 64, J1 = J0 + nctx * 1024, J2 = J1 + MT * 6, J3 = J2 + nu * 34 * 8;
        unsigned* ctr = qctr++;
        for (int job = next_job(ctr, sjob); job < J3; job = next_job(ctr, sjob)) {
          if (job < J0) {
            int ug = ulat0 + (job >> 6), r = job & 63, es = r & 7, ch = r >> 3, h = ch >> 1, dir = ch & 1;
            int b = ((g0 >> 12) + ug) - 1;
            hgrn_b<8>(p, l, ug * 64, 64, h, dir, es, p.state_hgrn + ((size_t)((b * 2 + l) * 2 + dir) * 4 + h) * 16384, nullptr, lds);
          } else if (job < J1) {
            int j = job - J0, es = j & 7, ch = j >> 3, dir = ch & 1, h = (ch >> 1) & 3, seq = ch >> 3;
            hgrn_b<4>(p, l, seq * 4, 4, h, dir, es, nullptr, p.out + O_ST + ((size_t)((seq * 2 + l) * 2 + dir) * 4 + h) * 16384, lds);
          } else if (job < J2) {
            int j = job - J1;
            gemmq_job(p, l, g0, j / 6, j % 6, lds);
          } else {
            int j = job - J2, ug = j / 272, r = j % 272, mt = r >> 3, nt = r & 7;
            bool isctx = (g0 + ug * UT) < UT;
            if (isctx && mt >= 32) continue;
            gemmkv_job(p, l, ug, mt, nt, lds);
          }
        }
      }
      xcd_barrier(xb);
      {
        {
          const int xq = bid & 7, local = bid >> 3, npairs = nu * 4;
          if (npairs == 12 && (nb >> 3) >= 48) {
            if (local < 32) mla_job(p, g0, xq >> 2, local, xq & 3, lds);
            else if (local < 48) { const int pp = 8 + (xq >> 1); mla_job(p, g0, pp >> 2, (xq & 1) * 16 + (local - 32), pp & 3, lds); }
          } else {
            const int npx = (npairs - xq + 7) >> 3;
            for (int jj = local; jj < 32 * npx; jj += (nb >> 3)) {
              const int pp = xq + 8 * (jj >> 5);
              mla_job(p, g0, pp >> 2, jj & 31, pp & 3, lds);
            }
          }
        }
        const int J1 = nu * 256, J2 = J1 + nu * 256;
        unsigned* ctr = qctr++;
        for (int job = next_job(ctr, sjob); job < J2; job = next_job(ctr, sjob)) {
          if (job < J1) {
            int ug = job >> 8, r = job & 255;
            na_wave(p, l, g0, ug, r >> 1, (r & 1) * 4 + (ltid() >> 6), lds);
          } else {
            int j = job - J1;
            hgrn_c(p, l, j >> 2, j & 3, lds);
          }
        }
      }
      xcd_barrier(xb);
      {
        const int xq = bid & 7, local = bid >> 3, hm = MT >> 1;
        for (int j = local; j < 2 * hm; j += (nb >> 3)) gemm3_job(p, l, (xq >> 2) * hm + (j >> 1), 2 * (xq & 3) + (j & 1), lds);
      }
      xcd_barrier(xb);
      {
        const int xq = bid & 7, local = bid >> 3, hm = MT >> 1;
        for (int j = local; j < 2 * hm; j += (nb >> 3)) gemm4_job(p, l, g0, (xq >> 2) * hm + (j >> 1), 2 * (xq & 3) + (j & 1), lds);
      }
      xcd_barrier(xb);
      for (int job = bid; job < nu * 256; job += nb) ln_job(p, l, g0, job);
      xcd_barrier(xb);
    }
  }
}

extern "C" void kernel_launch(void* const* d_in, const int* in_sizes, int n_in, void* d_out, int out_size, void* d_ws,
                              size_t ws_size, hipStream_t stream) {
  static int grid_blocks = 0;
  if (!grid_blocks) {
    int dev = 0, cus = 0, per_cu = 0;
    hipGetDevice(&dev);
    hipDeviceGetAttribute(&cus, hipDeviceAttributeMultiprocessorCount, dev);
    hipFuncSetAttribute((const void*)mega, hipFuncAttributeMaxDynamicSharedMemorySize, LDS_BYTES);
    hipOccupancyMaxActiveBlocksPerMultiprocessor(&per_cu, mega, 256, LDS_BYTES);
    if (per_cu > 2) per_cu = 2;
    if (per_cu < 1) per_cu = 1;
    grid_blocks = cus * per_cu;
  }
  if (ws_size < W_END) fprintf(stderr, "workspace too small: %zu < %zu\n", ws_size, (size_t)W_END);
  P p{};
  const float** pp = (const float**)&p;
  for (int i = 0; i < 25; ++i) pp[i] = (const float*)d_in[i];
  p.out = (float*)d_out;
  p.ws = (char*)d_ws;
  void* args[] = {&p};
  (void)hipMemsetAsync((char*)d_ws + W_CTR, 0, 16384, stream);
  hipError_t e = hipLaunchCooperativeKernel((const void*)mega, dim3(grid_blocks), dim3(256), args, LDS_BYTES, stream);
  if (e != hipSuccess) fprintf(stderr, "cooperative launch failed: %s (grid %d)\n", hipGetErrorString(e), grid_blocks);
}
```
